# Optimizing an MI355X kernel written in HIP

```python
import jax, jax.numpy as jnp
from jax import lax
import numpy as np

D_MODEL = 1024
BATCH = 16
SEQ = 2048
DEPTH = 1

D_MIX = D_MODEL
A_HEADS = 8
A_HEAD_DIM = 64
D_A = A_HEADS * A_HEAD_DIM
DILATED_BRANCHES = ((128, 1), (512, 4), (2048, 16))
BLK = 128
B_HEADS = 8
B_NOPE_DIM = 64
B_ROPE_DIM = 32
B_V_DIM = 64
D_B = B_HEADS * B_V_DIM
Q_LORA = 384
KV_LORA = 256
ROPE_THETA = 10000.0
P_IN = 3 * D_A + Q_LORA + KV_LORA + B_ROPE_DIM
N_BUCKETS = 32
MAX_DISTANCE = 2048
D_FF = ((-(-8 * D_MODEL // 3) + 255) // 256) * 256
N_MOD = 6
EPS = 1e-6
NEG = -1e30

kernel_name = 'hybrid_dilated_mla_adaln_layer'


def _rmsnorm(x, g):
    xf = x.astype(jnp.float32)
    y = xf * lax.rsqrt(jnp.mean(xf * xf, axis=-1, keepdims=True) + EPS)
    return (y * g.astype(jnp.float32)).astype(x.dtype)


def _t5_bucket(dist):
    max_exact = N_BUCKETS // 2
    d = np.maximum(dist, 1).astype(np.float64)
    large = max_exact + (np.log(d / max_exact) / np.log(MAX_DISTANCE / max_exact)
                         * (N_BUCKETS - max_exact)).astype(np.int64)
    large = np.minimum(large, N_BUCKETS - 1)
    return np.where(dist < max_exact, dist, large).astype(np.int32)


def _dilated_branch(q, k, v, rel_bias, window, dilation):
    B, S, H, E = q.shape
    span = window // dilation
    n = S // dilation
    nb = -(-n // BLK)
    n_pad = nb * BLK

    def to_residue(t):
        t = t.reshape(B, n, dilation, H, E).transpose(0, 2, 3, 1, 4)
        return jnp.pad(t, ((0, 0), (0, 0), (0, 0), (0, n_pad - n), (0, 0)))

    def band(t):
        t = jnp.pad(to_residue(t), ((0, 0), (0, 0), (0, 0), (BLK, 0), (0, 0)))
        t = t.reshape(B, dilation, H, nb + 1, BLK, E)
        return jnp.concatenate([t[:, :, :, :-1], t[:, :, :, 1:]], axis=4)

    qb = to_residue(q).reshape(B, dilation, H, nb, BLK, E)
    kb, vb = band(k), band(v)
    a = np.arange(BLK)[:, None]
    bk = np.arange(2 * BLK)[None, :]
    steps = BLK + a - bk
    valid = (steps >= 0) & (steps <= span)
    first = valid & (bk >= BLK)
    mask = np.concatenate([first[None], np.broadcast_to(valid, (nb - 1,) + valid.shape)], axis=0)
    bucket = _t5_bucket(np.clip(steps, 0, span) * dilation)
    bias = jnp.transpose(rel_bias[bucket], (2, 0, 1)).astype(jnp.float32)

    logits = jnp.einsum('bdhnqe,bdhnke->bdhnqk', qb, kb,
                        preferred_element_type=jnp.float32) * (E ** -0.5)
    logits = logits + bias[None, None, :, None]
    logits = jnp.where(jnp.asarray(mask)[None, None, None], logits, NEG)
    m = jnp.max(logits, axis=-1, keepdims=True)
    p = jnp.exp(logits - m)
    s = jnp.sum(p, axis=-1, keepdims=True)
    o = jnp.einsum('bdhnqk,bdhnke->bdhnqe', p, vb.astype(jnp.float32)) / s
    lse = (m + jnp.log(s))[..., 0]

    def from_residue(t):
        t = t.reshape((B, dilation, H, n_pad) + t.shape[5:])[:, :, :, :n]
        t = jnp.moveaxis(t, 3, 1)
        return t.reshape((B, S, H) + t.shape[4:])

    return from_residue(o), from_residue(lse)


def _rope(t):
    S, R = t.shape[1], t.shape[-1]
    half = R // 2
    inv = ROPE_THETA ** (-jnp.arange(half, dtype=jnp.float32) / half)
    ang = jnp.arange(S, dtype=jnp.float32)[:, None] * inv[None, :]
    cos, sin = jnp.cos(ang)[None, :, None], jnp.sin(ang)[None, :, None]
    t1, t2 = t[..., :half].astype(jnp.float32), t[..., half:].astype(jnp.float32)
    return jnp.concatenate([t1 * cos - t2 * sin, t1 * sin + t2 * cos], axis=-1).astype(t.dtype)


def _mla_attention(q_nope, q_rope, k_nope, k_rope, v):
    B, S, H, _ = q_nope.shape
    nq = S // BLK
    scale = (B_NOPE_DIM + B_ROPE_DIM) ** -0.5
    qn = jnp.moveaxis(q_nope.reshape(B, nq, BLK, H, -1), 1, 0)
    qr = jnp.moveaxis(q_rope.reshape(B, nq, BLK, H, -1), 1, 0)
    kpos = jnp.arange(S)

    def block(args):
        qn_b, qr_b, i = args
        logits = (jnp.einsum('bqhe,bkhe->bhqk', qn_b, k_nope, preferred_element_type=jnp.float32)
                  + jnp.einsum('bqhe,bke->bhqk', qr_b, k_rope, preferred_element_type=jnp.float32)) * scale
        qpos = i * BLK + jnp.arange(BLK)
        logits = jnp.where(qpos[:, None] >= kpos[None, :], logits, NEG)
        p = jax.nn.softmax(logits, axis=-1)
        return jnp.einsum('bhqk,bkhe->bqhe', p.astype(v.dtype), v)

    o = lax.map(block, (qn, qr, jnp.arange(nq)))
    return jnp.moveaxis(o, 0, 1).reshape(B, S, H, -1)


def _mixer(h, w_in, g_cq, w_uq, g_ckv, w_ukv, rel_bias, g_out_a, g_out_b, w_out):
    B, S, _ = h.shape
    proj = h @ w_in
    i1, i2, i3 = D_A, 2 * D_A, 3 * D_A
    i4, i5 = i3 + Q_LORA, i3 + Q_LORA + KV_LORA
    qa, ka, va, cq, ckv, kr = jnp.split(proj, [i1, i2, i3, i4, i5], axis=-1)
    qa = qa.reshape(B, S, A_HEADS, A_HEAD_DIM)
    ka = ka.reshape(B, S, A_HEADS, A_HEAD_DIM)
    va = va.reshape(B, S, A_HEADS, A_HEAD_DIM)
    branches = [_dilated_branch(qa, ka, va, rel_bias, w, d) for (w, d) in DILATED_BRANCHES]
    o_stack = jnp.stack([br[0] for br in branches])
    lse = jnp.stack([br[1] for br in branches])
    wts = jax.nn.softmax(lse, axis=0)
    out_a = jnp.einsum('rbsh,rbshe->bshe', wts, o_stack).reshape(B, S, D_A).astype(h.dtype)
    q = (_rmsnorm(cq, g_cq) @ w_uq).reshape(B, S, B_HEADS, B_NOPE_DIM + B_ROPE_DIM)
    q_nope, q_rope = q[..., :B_NOPE_DIM], _rope(q[..., B_NOPE_DIM:])
    kv = (_rmsnorm(ckv, g_ckv) @ w_ukv).reshape(B, S, B_HEADS, B_NOPE_DIM + B_V_DIM)
    k_nope, v = kv[..., :B_NOPE_DIM], kv[..., B_NOPE_DIM:]
    k_rope = _rope(kr[:, :, None, :])[:, :, 0]
    out_b = _mla_attention(q_nope, q_rope, k_nope, k_rope, v).reshape(B, S, D_B)
    y = jnp.concatenate([_rmsnorm(out_a, g_out_a), _rmsnorm(out_b, g_out_b)], axis=-1)
    return y @ w_out


def _swiglu(h, w_ffn_in, w_ffn_out):
    g, u = jnp.split(h @ w_ffn_in, 2, axis=-1)
    return (jax.nn.silu(g) * u) @ w_ffn_out


def setup_inputs(seed: int = 0) -> dict:
    key = jax.random.key(seed)
    ks = jax.random.split(key, 20)
    f32 = jnp.float32

    def nrm(k, shape, scale):
        return jax.random.normal(k, shape, f32) * scale

    def gain(k, shape):
        return 1.0 + 0.05 * jax.random.normal(k, shape, f32)

    L = DEPTH
    return {
        'x': nrm(ks[0], (BATCH, SEQ, D_MODEL), 1.0),
        'c': nrm(ks[1], (BATCH, D_MODEL), 1.0),
        'w_ada': nrm(ks[2], (L, D_MODEL, N_MOD * D_MODEL), 0.5 * D_MODEL ** -0.5),
        'b_ada': nrm(ks[3], (L, N_MOD * D_MODEL), 0.01),
        'g_norm1': gain(ks[4], (L, D_MODEL)),
        'w_in': nrm(ks[5], (L, D_MODEL, P_IN), D_MODEL ** -0.5),
        'g_cq': gain(ks[6], (L, Q_LORA)),
        'w_uq': nrm(ks[7], (L, Q_LORA, B_HEADS * (B_NOPE_DIM + B_ROPE_DIM)), Q_LORA ** -0.5),
        'g_ckv': gain(ks[8], (L, KV_LORA)),
        'w_ukv': nrm(ks[9], (L, KV_LORA, B_HEADS * (B_NOPE_DIM + B_V_DIM)), KV_LORA ** -0.5),
        'rel_bias': nrm(ks[10], (N_BUCKETS, A_HEADS), 0.5),
        'g_out_a': gain(ks[11], (L, D_A)),
        'g_out_b': gain(ks[12], (L, D_B)),
        'w_out': nrm(ks[13], (L, D_MIX, D_MODEL), D_MIX ** -0.5),
        'g_norm2': gain(ks[14], (L, D_MODEL)),
        'w_ffn_in': nrm(ks[15], (L, D_MODEL, 2 * D_FF), D_MODEL ** -0.5),
        'w_ffn_out': nrm(ks[16], (L, D_FF, D_MODEL), D_FF ** -0.5),
        'g_final': gain(ks[17], (D_MODEL,)),
    }


def reference(x, c, w_ada, b_ada, g_norm1, w_in, g_cq, w_uq, g_ckv, w_ukv, rel_bias,
              g_out_a, g_out_b, w_out, g_norm2, w_ffn_in, w_ffn_out, g_final):
    cond = jax.nn.silu(c)
    for l in range(DEPTH):
        mod = (cond @ w_ada[l] + b_ada[l])[:, None, :]
        sh1, sc1, g1, sh2, sc2, g2 = jnp.split(mod, N_MOD, axis=-1)
        h = _rmsnorm(x, g_norm1[l]) * (1.0 + sc1) + sh1
        x = x + g1 * _mixer(h, w_in[l], g_cq[l], w_uq[l], g_ckv[l], w_ukv[l], rel_bias,
                            g_out_a[l], g_out_b[l], w_out[l])
        h = _rmsnorm(x, g_norm2[l]) * (1.0 + sc2) + sh2
        x = x + g2 * _swiglu(h, w_ffn_in[l], w_ffn_out[l])
    return _rmsnorm(x, g_final)
```

```cpp
#include <hip/hip_runtime.h>
#include <hip/hip_cooperative_groups.h>
#include <cstdio>
#include <cstdint>
namespace cg = cooperative_groups;

#define LAS __attribute__((address_space(3)))
typedef unsigned short bf16_t;
typedef short bf16x8 __attribute__((ext_vector_type(8)));
typedef short s16x4 __attribute__((ext_vector_type(4)));
typedef float f32x4 __attribute__((ext_vector_type(4)));
typedef float f32x2 __attribute__((ext_vector_type(2)));
typedef float f32x16 __attribute__((ext_vector_type(16)));
typedef unsigned u32x4 __attribute__((ext_vector_type(4)));
typedef unsigned u32x2 __attribute__((ext_vector_type(2)));
typedef __bf16 bf16x2_t __attribute__((ext_vector_type(2)));

constexpr int NB = 16, SEQ = 2048, DM = 1024, T = NB * SEQ;
constexpr int PINP = 2304;
constexpr int QBW = 768, KVW = 1024, DFF = 2816;
constexpr int NMOD = 6 * DM;
constexpr float EPS = 1e-6f;
constexpr float LOG2E = 1.4426950408889634f;
constexpr float C2A = 0.18033688011112042f;
constexpr float C2B = 0.14724444602590306f;
constexpr float NEGBIG = -1e30f;
constexpr int PC_QA = 0, PC_KA = 512, PC_VA = 1024, PC_CQ = 1536, PC_KR = 1920, PC_CKV = 2048;

constexpr size_t MiB = 1u << 20;
constexpr size_t WS_MOD = 0;
constexpr size_t WS_SSQ = 512 * 1024;
constexpr size_t WS_ROPE = 1 * MiB;
constexpr size_t WS_LSE = 2 * MiB;
constexpr size_t WS_WIN = 8 * MiB;
constexpr size_t WS_WUQ = 13 * MiB;
constexpr size_t WS_WUKV = 14 * MiB;
constexpr size_t WS_WOUT = 15 * MiB;
constexpr size_t WS_WFFI = 17 * MiB;
constexpr size_t WS_WFFO = 28 * MiB;
constexpr size_t WS_PROJ = 40 * MiB;
constexpr size_t WS_QB = 184 * MiB;
constexpr size_t WS_HF = 40 * MiB;
constexpr size_t WS_KVB = 232 * MiB;
constexpr size_t WS_H = 296 * MiB;
constexpr size_t WS_OA = 296 * MiB;
constexpr size_t WS_OUTB = 392 * MiB;
constexpr size_t WS_Y = 424 * MiB;
constexpr size_t WS_END = 488 * MiB;

constexpr int LDS_BYTES = 147456;
constexpr int NWAVES = 8;

__device__ const float ROPE_INV[16] = {1.0f, 0.5623413251903491f, 0.31622776601683794f, 0.1778279410038923f, 0.1f, 0.05623413251903491f, 0.03162277660168379f,
    0.01778279410038923f, 0.01f, 0.005623413251903491f, 0.003162277660168379f, 0.001778279410038923f, 0.001f, 0.0005623413251903491f, 0.00031622776601683794f, 0.0001778279410038923f};

__device__ __forceinline__ unsigned cvtpk(float lo, float hi) { f32x2 v = {lo, hi}; bf16x2_t b = __builtin_convertvector(v, bf16x2_t); return __builtin_bit_cast(unsigned, b); }
__device__ __forceinline__ float bf2f(unsigned short h) { return __uint_as_float(((unsigned)h) << 16); }
__device__ __forceinline__ float wave_sum(float v) {
#pragma unroll
    for (int o = 1; o < 64; o <<= 1) v += __shfl_xor(v, o);
    return v;
}

namespace pg8 {
constexpr int BM = 256, BK = 64, HALF = 128, HTB = HALF * BK * 2, STAGE_BYTES = 8 * HTB, NXCD = 8, WGM = 8;
__host__ __device__ __forceinline__ int lds_byte(int r, int c) { const int st = (r >> 4) * 2 + (c >> 5), rr = r & 15, cc = c & 31, ob = rr * 64 + cc * 2; return st * 1024 + (ob ^ (((ob >> 9) & 1) << 5)); }
__host__ __device__ __forceinline__ void stage_rc(int b, int& R, int& C) { const int st = b / 1024, sb = b % 1024, swz = sb ^ (((sb >> 9) & 1) << 5); R = (st >> 1) * 16 + swz / 64; C = (st & 1) * 32 + (swz % 64) / 2; }
__host__ __device__ __forceinline__ int perm32(int rho) { const int n = rho >> 4, i = rho & 15; return 8 * (i >> 2) + 4 * n + (i & 3); }

struct Unit { int pm, pn; };
struct Gemm { const bf16_t* A; const bf16_t* Bt; int M, N, K, lda, ldb; };

struct StaticOrder {
    int nM, nN, nwg, G, c;
    __device__ void init(int M, int N, int G_, int c_) { nM = M / BM; nN = N / BM; nwg = nM * nN; G = G_; c = c_; }
    __device__ bool next(int i, Unit& u) const {
        const long L = (long)i * G + c; if (L >= nwg) return false;
        int wgid = (int)L; { const int q = nwg / NXCD, r = nwg % NXCD, xcd = wgid % NXCD, off = wgid / NXCD; wgid = (xcd < r ? xcd * (q + 1) : r * (q + 1) + (xcd - r) * q) + off; }
        const int nig = WGM * nN, gid = wgid / nig, fm = gid * WGM, gsz = (nM - fm) < WGM ? (nM - fm) : WGM;
        u.pm = fm + ((wgid % nig) % gsz); u.pn = (wgid % nig) / gsz; return true;
    }
};

template <class Epi>
__device__ __forceinline__ void gemm_phase(LAS unsigned char* lds, const Gemm g, const StaticOrder& S, const Epi& E, const int tid) {
    const int wid = __builtin_amdgcn_readfirstlane(tid >> 6), lane = tid & 63, wr = wid >> 2, wc = wid & 3, fr = lane & 15, fq = lane >> 4;
    const int K = g.K, nt = K / BK;
    unsigned voffA[2], voffB[2];
#pragma unroll
    for (int i = 0; i < 2; ++i) { int R, C; stage_rc(tid * 16 + i * 8192, R, C); const int Rb = Epi::PERM ? ((R & ~31) + perm32(R & 31)) : R;
        voffA[i] = (unsigned)(R * g.lda + C) * 2u; voffB[i] = (unsigned)(Rb * g.ldb + C) * 2u; }
    const size_t kstep = (size_t)(BK * 2);
    const size_t hstepA = (size_t)HALF * g.lda * 2, hstepB = (size_t)HALF * g.ldb * 2;
    const size_t tstepA = 2 * hstepA, tstepB = 2 * hstepB;
    const unsigned ldsw = (unsigned)wid * 1024u;
    const int aoff = lds_byte(wr * 64 + fr, fq * 8), boff = lds_byte(wc * 32 + fr, fq * 8);
#define PG8_SA(b, h) (((b) * 2 + (h)) * HTB)
#define PG8_SB(b, h) ((4 + (b) * 2 + (h)) * HTB)
#define PG8_STAGE(bufoff, gbase, voff) do { _Pragma("unroll") for (int _i = 0; _i < 2; ++_i) \
        __builtin_amdgcn_global_load_lds((const unsigned*)((const char*)(gbase) + (voff)[_i]), (LAS unsigned*)(lds + (bufoff) + ldsw + _i * 8192), 16, 0, 0); } while (0)
#define PG8_LDA(dst, b, h) do { _Pragma("unroll") for (int m = 0; m < 4; ++m) _Pragma("unroll") for (int k = 0; k < 2; ++k) dst[m][k] = *(const LAS bf16x8*)(lds + PG8_SA(b, h) + aoff + m * 2048 + k * 1024); } while (0)
#define PG8_LDB(dst, b, h) do { _Pragma("unroll") for (int n = 0; n < 2; ++n) _Pragma("unroll") for (int k = 0; k < 2; ++k) dst[n][k] = *(const LAS bf16x8*)(lds + PG8_SB(b, h) + boff + n * 2048 + k * 1024); } while (0)
#define PG8_MMA(ai, bj, At, Bt) do { __builtin_amdgcn_s_setprio(1); _Pragma("unroll") for (int m = 0; m < 4; ++m) _Pragma("unroll") for (int n = 0; n < 2; ++n) _Pragma("unroll") for (int k = 0; k < 2; ++k) \
        acc[ai][bj][m][n] = __builtin_amdgcn_mfma_f32_16x16x32_bf16(Bt[n][k], At[m][k], acc[ai][bj][m][n], 0, 0, 0); __builtin_amdgcn_s_setprio(0); } while (0)
#define PG8_WAIT_V(n) asm volatile("s_waitcnt vmcnt(" #n ")" ::: "memory")
#define PG8_WAIT_L(n) asm volatile("s_waitcnt lgkmcnt(" #n ")" ::: "memory")
#define PG8_BAR __builtin_amdgcn_s_barrier()
#define PG8_SCHED __builtin_amdgcn_sched_barrier(0)
    Unit cur, nxt; int ui = 0;
    if (!S.next(0, cur)) return;
    f32x4 acc[2][2][4][2];
#pragma unroll
    for (int a = 0; a < 2; ++a)
#pragma unroll
        for (int b = 0; b < 2; ++b)
#pragma unroll
            for (int m = 0; m < 4; ++m)
#pragma unroll
                for (int n = 0; n < 2; ++n) acc[a][b][m][n] = (f32x4){0.f, 0.f, 0.f, 0.f};
    bf16x8 At[4][2], B0[2][2], B1[2][2];
    const char* cA = (const char*)g.A + (size_t)cur.pm * tstepA; const char* cB = (const char*)g.Bt + (size_t)cur.pn * tstepB;
    PG8_STAGE(PG8_SB(0, 0), cB, voffB); PG8_STAGE(PG8_SB(0, 1), cB + hstepB, voffB); PG8_STAGE(PG8_SA(0, 0), cA, voffA); PG8_STAGE(PG8_SA(0, 1), cA + hstepA, voffA);
    if (wr == 1) PG8_BAR;
    PG8_WAIT_V(2); PG8_BAR;
    PG8_STAGE(PG8_SB(1, 0), cB + kstep, voffB); PG8_STAGE(PG8_SA(1, 0), cA + kstep, voffA); PG8_STAGE(PG8_SB(1, 1), cB + hstepB + kstep, voffB);
    PG8_WAIT_V(6); PG8_BAR;
    for (;;) {
        const bool has_next = S.next(ui + 1, nxt);
        const char* nA = has_next ? (const char*)g.A + (size_t)nxt.pm * tstepA : cA; const char* nB = has_next ? (const char*)g.Bt + (size_t)nxt.pn * tstepB : cB;
#pragma unroll 1
        for (int t = 0; t < nt; t += 2) {
            const bool last = (t == nt - 2);
            const char* a1 = cA + (size_t)(t + 1) * kstep;
            const char* a2 = last ? nA : cA + (size_t)(t + 2) * kstep; const char* b2 = last ? nB : cB + (size_t)(t + 2) * kstep;
            const char* a3 = a2 + kstep; const char* b3 = b2 + kstep;
            PG8_LDB(B0, 0, 0); PG8_LDB(B1, 0, 1); PG8_SCHED; PG8_LDA(At, 0, 0); PG8_STAGE(PG8_SA(1, 1), a1 + hstepA, voffA);
            PG8_WAIT_V(8); PG8_WAIT_L(0); PG8_BAR; PG8_MMA(0, 0, At, B0); PG8_MMA(0, 1, At, B1); PG8_BAR; PG8_SCHED;
            PG8_LDA(At, 0, 1); PG8_STAGE(PG8_SB(0, 0), b2, voffB); PG8_STAGE(PG8_SB(0, 1), b2 + hstepB, voffB); PG8_STAGE(PG8_SA(0, 0), a2, voffA);
            PG8_WAIT_V(8); PG8_WAIT_L(0); PG8_BAR; PG8_MMA(1, 0, At, B0); PG8_MMA(1, 1, At, B1); PG8_BAR; PG8_SCHED;
            PG8_LDB(B0, 1, 0); PG8_LDB(B1, 1, 1); PG8_SCHED; PG8_LDA(At, 1, 0); PG8_STAGE(PG8_SA(0, 1), a2 + hstepA, voffA);
            PG8_WAIT_V(8); PG8_WAIT_L(0); PG8_BAR; PG8_MMA(0, 0, At, B0); PG8_MMA(0, 1, At, B1); PG8_BAR; PG8_SCHED;
            PG8_LDA(At, 1, 1); PG8_STAGE(PG8_SB(1, 0), b3, voffB); PG8_STAGE(PG8_SB(1, 1), b3 + hstepB, voffB); PG8_STAGE(PG8_SA(1, 0), a3, voffA);
            PG8_WAIT_V(8); PG8_WAIT_L(0); PG8_BAR; PG8_MMA(1, 0, At, B0); PG8_MMA(1, 1, At, B1); PG8_BAR; PG8_SCHED;
        }
        if (wr == 0) PG8_BAR;
        E(acc, cur, wr, wc, fr, fq);
        if (!has_next) break;
#pragma unroll
        for (int a = 0; a < 2; ++a)
#pragma unroll
            for (int b = 0; b < 2; ++b)
#pragma unroll
                for (int m = 0; m < 4; ++m)
#pragma unroll
                    for (int n = 0; n < 2; ++n) acc[a][b][m][n] = (f32x4){0.f, 0.f, 0.f, 0.f};
        cur = nxt; cA = nA; cB = nB; ++ui;
        if (wr == 1) PG8_BAR;
    }
    PG8_WAIT_V(0);
    PG8_BAR;
#undef PG8_SA
#undef PG8_SB
#undef PG8_STAGE
#undef PG8_LDA
#undef PG8_LDB
#undef PG8_MMA
#undef PG8_WAIT_V
#undef PG8_WAIT_L
#undef PG8_BAR
#undef PG8_SCHED
}

typedef const f32x4 (&AccRef)[2][2][4][2];

struct EpiProj {
    static constexpr bool PERM = true;
    bf16_t* O; float* ssq; const f32x2* rt;
    __device__ __forceinline__ void operator()(AccRef acc, const Unit& u, int wr, int wc, int fr, int fq) const {
        const int row0 = u.pm * BM + wr * 64 + fr;
#pragma unroll
        for (int bj = 0; bj < 2; ++bj) {
            const int cgi = u.pn * 8 + bj * 4 + wc;
            const int col0 = cgi * 32 + 8 * fq;
            if (cgi >= 61 && cgi < 64) continue;
            if (cgi == 60) {
                const int ib = 8 * (fq & 1);
#pragma unroll
                for (int ai = 0; ai < 2; ++ai)
#pragma unroll
                    for (int m = 0; m < 4; ++m) {
                        const int row = row0 + ai * HALF + m * 16; const int pos = row & (SEQ - 1);
                        float o[8];
#pragma unroll
                        for (int n = 0; n < 2; ++n)
#pragma unroll
                            for (int j = 0; j < 4; ++j) { const float v = acc[ai][bj][m][n][j]; const float p = __shfl_xor(v, 32); const f32x2 cs = rt[pos * 16 + ib + 4 * n + j];
                                o[4 * n + j] = v * cs.x + (fq < 2 ? -p : p) * cs.y; }
                        u32x4 w; w.x = cvtpk(o[0], o[1]); w.y = cvtpk(o[2], o[3]); w.z = cvtpk(o[4], o[5]); w.w = cvtpk(o[6], o[7]);
                        *(u32x4*)(O + (size_t)row * PINP + col0) = w;
                    }
                continue;
            }
            const float sc = cgi < 16 ? C2A : 1.f;
            const bool stat = (cgi >= 48 && cgi < 60) || cgi >= 64;
            const int which = cgi >= 64 ? 1 : 0;
#pragma unroll
            for (int ai = 0; ai < 2; ++ai)
#pragma unroll
                for (int m = 0; m < 4; ++m) {
                    const int row = row0 + ai * HALF + m * 16;
                    const f32x4 v0 = acc[ai][bj][m][0], v1 = acc[ai][bj][m][1];
                    u32x4 w; w.x = cvtpk(v0[0] * sc, v0[1] * sc); w.y = cvtpk(v0[2] * sc, v0[3] * sc); w.z = cvtpk(v1[0] * sc, v1[1] * sc); w.w = cvtpk(v1[2] * sc, v1[3] * sc);
                    *(u32x4*)(O + (size_t)row * PINP + col0) = w;
                    if (stat) {
                        float s = (v0[0] * v0[0] + v0[1] * v0[1]) + (v0[2] * v0[2] + v0[3] * v0[3]) + (v1[0] * v1[0] + v1[1] * v1[1]) + (v1[2] * v1[2] + v1[3] * v1[3]);
                        s += __shfl_xor(s, 16); s += __shfl_xor(s, 32);
                        if (fq == 0) atomicAdd(ssq + (size_t)row * 2 + which, s);
                    }
                }
        }
    }
};
struct EpiQ {
    static constexpr bool PERM = true;
    bf16_t* O; const float* ssq; const f32x2* rt;
    __device__ __forceinline__ void operator()(AccRef acc, const Unit& u, int wr, int wc, int fr, int fq) const {
        const int row0 = u.pm * BM + wr * 64 + fr;
        float rs[2][4];
#pragma unroll
        for (int ai = 0; ai < 2; ++ai)
#pragma unroll
            for (int m = 0; m < 4; ++m) rs[ai][m] = rsqrtf(ssq[(size_t)(row0 + ai * HALF + m * 16) * 2] * (1.0f / 384.0f) + EPS) * C2B;
#pragma unroll
        for (int bj = 0; bj < 2; ++bj) {
            const int cgi = u.pn * 8 + bj * 4 + wc;
            const int col0 = cgi * 32 + 8 * fq;
            const bool rope = cgi >= 16;
            const int ib = 8 * (fq & 1);
#pragma unroll
            for (int ai = 0; ai < 2; ++ai)
#pragma unroll
                for (int m = 0; m < 4; ++m) {
                    const int row = row0 + ai * HALF + m * 16; const int pos = row & (SEQ - 1); const float r = rs[ai][m];
                    float o[8];
#pragma unroll
                    for (int n = 0; n < 2; ++n)
#pragma unroll
                        for (int j = 0; j < 4; ++j) { const float v = acc[ai][bj][m][n][j] * r;
                            if (rope) { const float p = __shfl_xor(v, 32); const f32x2 cs = rt[pos * 16 + ib + 4 * n + j]; o[4 * n + j] = v * cs.x + (fq < 2 ? -p : p) * cs.y; }
                            else o[4 * n + j] = v; }
                    u32x4 w; w.x = cvtpk(o[0], o[1]); w.y = cvtpk(o[2], o[3]); w.z = cvtpk(o[4], o[5]); w.w = cvtpk(o[6], o[7]);
                    *(u32x4*)(O + (size_t)row * QBW + col0) = w;
                }
        }
    }
};
struct EpiKV {
    static constexpr bool PERM = true;
    bf16_t* O; const float* ssq;
    __device__ __forceinline__ void operator()(AccRef acc, const Unit& u, int wr, int wc, int fr, int fq) const {
        const int row0 = u.pm * BM + wr * 64 + fr;
#pragma unroll
        for (int ai = 0; ai < 2; ++ai)
#pragma unroll
            for (int m = 0; m < 4; ++m) {
                const int row = row0 + ai * HALF + m * 16;
                const float r = rsqrtf(ssq[(size_t)row * 2 + 1] * (1.0f / 256.0f) + EPS);
#pragma unroll
                for (int bj = 0; bj < 2; ++bj) {
                    const int col0 = u.pn * BM + bj * HALF + wc * 32 + 8 * fq;
                    const f32x4 v0 = acc[ai][bj][m][0] * r, v1 = acc[ai][bj][m][1] * r;
                    u32x4 w; w.x = cvtpk(v0[0], v0[1]); w.y = cvtpk(v0[2], v0[3]); w.z = cvtpk(v1[0], v1[1]); w.w = cvtpk(v1[2], v1[3]);
                    *(u32x4*)(O + (size_t)row * KVW + col0) = w;
                }
            }
    }
};
struct EpiResGate {
    static constexpr bool PERM = false;
    const float* base; float* out; const float* gate;
    __device__ __forceinline__ void operator()(AccRef acc, const Unit& u, int wr, int wc, int fr, int fq) const {
        const int row0 = u.pm * BM + wr * 64 + fr;
        const float* gp = gate + (size_t)(u.pm >> 3) * NMOD;
#pragma unroll
        for (int bj = 0; bj < 2; ++bj)
#pragma unroll
            for (int n = 0; n < 2; ++n) {
                const int col = u.pn * BM + bj * HALF + wc * 32 + 16 * n + 4 * fq;
                const f32x4 gv = *(const f32x4*)(gp + col);
#pragma unroll
                for (int ai = 0; ai < 2; ++ai)
#pragma unroll
                    for (int m = 0; m < 4; ++m) {
                        const size_t off = (size_t)(row0 + ai * HALF + m * 16) * DM + col;
                        const f32x4 bs = *(const f32x4*)(base + off);
                        *(f32x4*)(out + off) = bs + gv * acc[ai][bj][m][n];
                    }
            }
    }
};
struct EpiSwiglu {
    static constexpr bool PERM = true;
    bf16_t* O;
    __device__ __forceinline__ void operator()(AccRef acc, const Unit& u, int wr, int wc, int fr, int fq) const {
        const int row0 = u.pm * BM + wr * 64 + fr;
        const int col0 = u.pn * HALF + wc * 32 + 8 * fq;
#pragma unroll
        for (int ai = 0; ai < 2; ++ai)
#pragma unroll
            for (int m = 0; m < 4; ++m) {
                const int row = row0 + ai * HALF + m * 16;
                float o[8];
#pragma unroll
                for (int n = 0; n < 2; ++n)
#pragma unroll
                    for (int j = 0; j < 4; ++j) { const float gte = acc[ai][0][m][n][j], up = acc[ai][1][m][n][j];
                        o[4 * n + j] = gte * __builtin_amdgcn_rcpf(1.0f + __builtin_amdgcn_exp2f(-gte * LOG2E)) * up; }
                u32x4 w; w.x = cvtpk(o[0], o[1]); w.y = cvtpk(o[2], o[3]); w.z = cvtpk(o[4], o[5]); w.w = cvtpk(o[6], o[7]);
                *(u32x4*)(O + (size_t)row * DFF + col0) = w;
            }
    }
};
}

typedef LAS const unsigned char* lds_cptr;
__device__ __forceinline__ int crow(int r, int hi) { return (r & 3) + 8 * (r >> 2) + 4 * hi; }
__device__ __forceinline__ s16x4 vtr(lds_cptr p) { typedef short v4i16_t __attribute__((ext_vector_type(4))); return __builtin_bit_cast(s16x4, __builtin_amdgcn_ds_read_tr16_b64_v4i16((LAS v4i16_t*)p)); }
__device__ __forceinline__ float swapmax(float m) { auto rr = __builtin_amdgcn_permlane32_swap(__float_as_uint(m), __float_as_uint(m), false, false); return fmaxf(__uint_as_float(rr[0]), __uint_as_float(rr[1])); }
__device__ __forceinline__ float swapsum(float m) { auto rr = __builtin_amdgcn_permlane32_swap(__float_as_uint(m), __float_as_uint(m), false, false); return __uint_as_float(rr[0]) + __uint_as_float(rr[1]); }

template <int ND>
__device__ __forceinline__ void qk_tile(f32x16& p0, f32x16& p1, lds_cptr kslot, int kstride, const bf16x8* qr, int r32, int hi) {
    lds_cptr kb = kslot + r32 * kstride + hi * 16;
    p0 = f32x16{}; p1 = f32x16{};
#pragma unroll
    for (int d0 = 0; d0 < ND; ++d0) {
        const bf16x8 b0 = *(const LAS bf16x8*)(kb + d0 * 32);
        const bf16x8 b1 = *(const LAS bf16x8*)(kb + 32 * kstride + d0 * 32);
        p0 = __builtin_amdgcn_mfma_f32_32x32x16_bf16(b0, qr[d0], p0, 0, 0, 0);
        p1 = __builtin_amdgcn_mfma_f32_32x32x16_bf16(b1, qr[d0], p1, 0, 0, 0);
    }
}
__device__ __forceinline__ void softmax_pv(f32x16& p0, f32x16& p1, float& mrun, float& lrun, f32x16 (&o)[2], LAS float* wsf, lds_cptr vslot, int lane, int r32, int hi) {
    float a = fmaxf(p0[0], p1[0]);
#pragma unroll
    for (int r = 1; r < 16; ++r) a = fmaxf(a, fmaxf(p0[r], p1[r]));
    const float rm = swapmax(a);
    const float mn = fmaxf(mrun, rm);
    const float f = __builtin_amdgcn_exp2f(mrun - mn);
    mrun = mn;
    float s = 0.f;
#pragma unroll
    for (int r = 0; r < 16; ++r) { p0[r] = __builtin_amdgcn_exp2f(p0[r] - mn); p1[r] = __builtin_amdgcn_exp2f(p1[r] - mn); s += p0[r] + p1[r]; }
    lrun = lrun * f + s;
    if (hi == 0) wsf[r32] = f;
    asm volatile("s_waitcnt lgkmcnt(0)" ::: "memory");
#pragma unroll
    for (int r = 0; r < 16; ++r) { const float fr_ = wsf[crow(r, hi)]; o[0][r] *= fr_; o[1][r] *= fr_; }
    asm volatile("s_waitcnt lgkmcnt(0)" ::: "memory");
    u32x4 pw[4];
    pw[0] = (u32x4){cvtpk(p0[0], p0[1]), cvtpk(p0[2], p0[3]), cvtpk(p0[4], p0[5]), cvtpk(p0[6], p0[7])};
    pw[1] = (u32x4){cvtpk(p0[8], p0[9]), cvtpk(p0[10], p0[11]), cvtpk(p0[12], p0[13]), cvtpk(p0[14], p0[15])};
    pw[2] = (u32x4){cvtpk(p1[0], p1[1]), cvtpk(p1[2], p1[3]), cvtpk(p1[4], p1[5]), cvtpk(p1[6], p1[7])};
    pw[3] = (u32x4){cvtpk(p1[8], p1[9]), cvtpk(p1[10], p1[11]), cvtpk(p1[12], p1[13]), cvtpk(p1[14], p1[15])};
    lds_cptr vp = vslot + ((lane >> 4) & 1) * 32 + (lane & 3) * 8 + (4 * hi + ((lane & 15) >> 2)) * 64;
#pragma unroll
    for (int d0 = 0; d0 < 2; ++d0)
#pragma unroll
        for (int ks = 0; ks < 4; ++ks) {
            const s16x4 lo = vtr(vp + d0 * 4096 + ks * 1024), hh = vtr(vp + d0 * 4096 + ks * 1024 + 512);
            const bf16x8 vb = (bf16x8){lo[0], lo[1], lo[2], lo[3], hh[0], hh[1], hh[2], hh[3]};
            o[d0] = __builtin_amdgcn_mfma_f32_32x32x16_bf16(__builtin_bit_cast(bf16x8, pw[ks]), vb, o[d0], 0, 0, 0);
        }
}
template <class RowPtr>
__device__ __forceinline__ float attn_finish(f32x16 (&o)[2], float mrun, float lrun, LAS float* wsf, LAS bf16_t* stg, int lane, int r32, int hi, const RowPtr& rowptr) {
    const float lt = swapsum(lrun);
    asm volatile("s_waitcnt lgkmcnt(0)" ::: "memory");
    if (hi == 0) wsf[32 + r32] = lt;
    asm volatile("s_waitcnt lgkmcnt(0)" ::: "memory");
#pragma unroll
    for (int r = 0; r < 16; ++r) { const int orow = crow(r, hi); const float rl = __builtin_amdgcn_rcpf(wsf[32 + orow]);
#pragma unroll
        for (int d0 = 0; d0 < 2; ++d0) stg[orow * 64 + d0 * 32 + r32] = (bf16_t)(cvtpk(o[d0][r] * rl, 0.f) & 0xffffu); }
    asm volatile("s_waitcnt lgkmcnt(0)" ::: "memory");
#pragma unroll
    for (int i = 0; i < 4; ++i) { const int row = i * 8 + (lane >> 3), ch = lane & 7; const u32x4 v = *(const LAS u32x4*)(stg + row * 64 + ch * 8); *(u32x4*)(rowptr(row) + ch * 8) = v; }
    asm volatile("s_waitcnt lgkmcnt(0)" ::: "memory");
    return mrun + __log2f(lt);
}

struct Args { const float* in[18]; float* out; unsigned char* ws; };
enum { I_X = 0, I_C, I_WADA, I_BADA, I_GN1, I_WIN, I_GCQ, I_WUQ, I_GCKV, I_WUKV, I_RELB, I_GOA, I_GOB, I_WOUT, I_GN2, I_WFFI, I_WFFO, I_GFIN };

__device__ __forceinline__ void tr_item(const float* W, int N, int k0, int n0src, const float* ksc, bf16_t* WT, int K, int drow0, LAS float* scr, int lane) {
#pragma unroll 8
    for (int i = 0; i < 32; ++i) { const int kk = 2 * i + (lane >> 5); float v = 0.f; if (n0src >= 0) v = W[(size_t)(k0 + kk) * N + n0src + (lane & 31)]; if (ksc) v *= ksc[k0 + kk]; scr[kk * 33 + (lane & 31)] = v; }
    asm volatile("s_waitcnt lgkmcnt(0)" ::: "memory");
    const int c = lane & 7;
#pragma unroll
    for (int j = 0; j < 4; ++j) { const int n = (lane >> 3) + 8 * j; const LAS float* s = scr + (8 * c) * 33 + n;
        u32x4 o; o.x = cvtpk(s[0 * 33], s[1 * 33]); o.y = cvtpk(s[2 * 33], s[3 * 33]); o.z = cvtpk(s[4 * 33], s[5 * 33]); o.w = cvtpk(s[6 * 33], s[7 * 33]);
        *(u32x4*)(WT + (size_t)(drow0 + n) * K + k0 + 8 * c) = o; }
    asm volatile("s_waitcnt lgkmcnt(0)" ::: "memory");
}

__device__ __forceinline__ void norm_row_bf16(const float* xrow, const float* gain, const float* sc, const float* sh, bf16_t* orow, int lane) {
    const f32x4* xr = (const f32x4*)xrow + lane;
    f32x4 v[4]; float s = 0.f;
#pragma unroll
    for (int j = 0; j < 4; ++j) { v[j] = xr[64 * j]; s += (v[j].x * v[j].x + v[j].y * v[j].y) + (v[j].z * v[j].z + v[j].w * v[j].w); }
    const float rstd = rsqrtf(wave_sum(s) * (1.f / DM) + EPS);
#pragma unroll
    for (int j = 0; j < 4; ++j) {
        const int col = 4 * lane + 256 * j;
        const f32x4 g = *(const f32x4*)(gain + col), a = *(const f32x4*)(sc + col), b = *(const f32x4*)(sh + col);
        const f32x4 y = v[j] * rstd * g * (a + 1.0f) + b;
        u32x2 w; w.x = cvtpk(y.x, y.y); w.y = cvtpk(y.z, y.w);
        *(u32x2*)(orow + col) = w;
    }
}

__device__ __forceinline__ int t5_bucket(int d) {
    if (d < 16) return d;
    int b = 16;
    b += (d >= 22); b += (d >= 30); b += (d >= 40); b += (d >= 54); b += (d >= 73); b += (d >= 99); b += (d >= 134); b += (d >= 182);
    b += (d >= 246); b += (d >= 332); b += (d >= 450); b += (d >= 609); b += (d >= 825); b += (d >= 1117); b += (d >= 1513);
    return b;
}

#define PHASE_BEGIN \
    int tid = threadIdx.x; asm volatile("" : "+v"(tid)); \
    const int lane = tid & 63, wave = __builtin_amdgcn_readfirstlane(tid >> 6); \
    const KArgs* kp = (const KArgs*)__builtin_amdgcn_kernarg_segment_ptr(); asm volatile("" : "+s"(kp)); \
    unsigned char* ws = kp->ws; \
    const int G = gridDim.x, bx = blockIdx.x; \
    const int vcu = (bx % 8) * (G / 8) + bx / 8; \
    const int gw = vcu * NWAVES + wave, NGW = G * NWAVES; \
    (void)lane; (void)gw; (void)NGW; (void)ws; (void)vcu;
#define WSP(type, off) ((type*)(ws + (off)))
typedef const __attribute__((address_space(4))) Args KArgs;

__global__ void __launch_bounds__(512, 2) fwd_kernel(Args args_unused) {
    extern __shared__ __attribute__((aligned(16))) unsigned char lds_raw[];
    LAS unsigned char* lds = (LAS unsigned char*)lds_raw;
    cg::grid_group grid = cg::this_grid();

    {
        PHASE_BEGIN
        for (int i = bx * 512 + tid; i < T * 2; i += G * 512) WSP(float, WS_SSQ)[i] = 0.f;
        for (int i = bx * 512 + tid; i < SEQ * 16; i += G * 512) {
            const int pos = i >> 4, k = i & 15;
            const float ang = (float)pos * ROPE_INV[k];
            const double rev = (double)ang * 0.15915494309189535;
            const float fr_ = (float)(rev - __builtin_rint(rev));
            WSP(f32x2, WS_ROPE)[i] = (f32x2){__builtin_amdgcn_cosf(fr_), __builtin_amdgcn_sinf(fr_)};
        }
        if (bx < NMOD / 32) {
            LAS float* sl = (LAS float*)lds;
            LAS float* red = (LAS float*)(lds + 65536);
            const float* c = kp->in[I_C];
            for (int i = tid; i < NB * DM; i += 512) { const float v = c[i]; sl[i] = v / (1.0f + __expf(-v)); }
            __syncthreads();
            const int col = tid & 31, ks = tid >> 5;
            const float* wp = kp->in[I_WADA] + (size_t)(ks * 64) * NMOD + bx * 32 + col;
            float acc[16];
#pragma unroll
            for (int b = 0; b < 16; ++b) acc[b] = 0.f;
#pragma unroll 4
            for (int kk = 0; kk < 64; ++kk) { const float w = wp[(size_t)kk * NMOD];
#pragma unroll
                for (int b = 0; b < 16; ++b) acc[b] += sl[b * DM + ks * 64 + kk] * w; }
#pragma unroll
            for (int b = 0; b < 16; ++b) red[(ks * 16 + b) * 32 + col] = acc[b];
            __syncthreads();
            { const int b = tid >> 5; float s = 0.f;
#pragma unroll
              for (int k2 = 0; k2 < 16; ++k2) s += red[(k2 * 16 + b) * 32 + col];
              WSP(float, WS_MOD)[b * NMOD + bx * 32 + col] = s + kp->in[I_BADA][bx * 32 + col]; }
            __syncthreads();
        }
        LAS float* scr = (LAS float*)(lds + wave * 16384);
        constexpr int IT_IN = 16 * 72, IT_UQ = 6 * 24, IT_UKV = 4 * 32, IT_OUT = 16 * 32, IT_FFI = 16 * 176, IT_FFO = 44 * 32;
        constexpr int NITEMS = IT_IN + IT_UQ + IT_UKV + IT_OUT + IT_FFI + IT_FFO;
        for (int it = gw; it < NITEMS; it += NGW) {
            int r = it;
            if (r < IT_IN) { const int kb = r / 72, nb = r % 72; const int src = nb < 60 ? 32 * nb : (nb == 60 ? 2176 : (nb < 64 ? -1 : 1920 + 32 * (nb - 64)));
                tr_item(kp->in[I_WIN], 2208, 64 * kb, src, nullptr, WSP(bf16_t, WS_WIN), 1024, 32 * nb, scr, lane); continue; } r -= IT_IN;
            if (r < IT_UQ) { const int kb = r / 24, nb = r % 24; const int src = nb < 16 ? (nb >> 1) * 96 + (nb & 1) * 32 : (nb - 16) * 96 + 64;
                tr_item(kp->in[I_WUQ], 768, 64 * kb, src, kp->in[I_GCQ], WSP(bf16_t, WS_WUQ), 384, 32 * nb, scr, lane); continue; } r -= IT_UQ;
            if (r < IT_UKV) { const int kb = r / 32, nb = r % 32; const int src = nb < 16 ? (nb >> 1) * 128 + (nb & 1) * 32 : ((nb - 16) >> 1) * 128 + 64 + (nb & 1) * 32;
                tr_item(kp->in[I_WUKV], 1024, 64 * kb, src, kp->in[I_GCKV], WSP(bf16_t, WS_WUKV), 256, 32 * nb, scr, lane); continue; } r -= IT_UKV;
            if (r < IT_OUT) { const int kb = r / 32, nb = r % 32; const float* ks_ = kb < 8 ? kp->in[I_GOA] : kp->in[I_GOB] - 512;
                tr_item(kp->in[I_WOUT], 1024, 64 * kb, 32 * nb, ks_, WSP(bf16_t, WS_WOUT), 1024, 32 * nb, scr, lane); continue; } r -= IT_OUT;
            if (r < IT_FFI) { const int kb = r / 176, nb = r % 176; const int pn = nb >> 3, w = nb & 7; const int src = w < 4 ? 128 * pn + 32 * w : DFF + 128 * pn + 32 * (w - 4);
                tr_item(kp->in[I_WFFI], 2 * DFF, 64 * kb, src, nullptr, WSP(bf16_t, WS_WFFI), 1024, 32 * nb, scr, lane); continue; } r -= IT_FFI;
            { const int kb = r / 32, nb = r % 32; tr_item(kp->in[I_WFFO], 1024, 64 * kb, 32 * nb, nullptr, WSP(bf16_t, WS_WFFO), DFF, 32 * nb, scr, lane); }
        }
    }
    grid.sync();
    { PHASE_BEGIN
    for (int m = gw; m < T; m += NGW) { const float* md = WSP(float, WS_MOD) + (size_t)(m >> 11) * NMOD; norm_row_bf16(kp->in[I_X] + (size_t)m * DM, kp->in[I_GN1], md + 1024, md, WSP(bf16_t, WS_H) + (size_t)m * DM, lane); } }
    grid.sync();
    {
        PHASE_BEGIN
        pg8::Gemm g{WSP(bf16_t, WS_H), WSP(bf16_t, WS_WIN), T, PINP, DM, DM, DM}; pg8::StaticOrder S; S.init(T, PINP, G, bx);
        pg8::EpiProj E{WSP(bf16_t, WS_PROJ), WSP(float, WS_SSQ), WSP(f32x2, WS_ROPE)};
        pg8::gemm_phase(lds, g, S, E, tid);
    }
    grid.sync();
    {
        { PHASE_BEGIN pg8::Gemm g{WSP(bf16_t, WS_PROJ) + PC_CQ, WSP(bf16_t, WS_WUQ), T, QBW, 384, PINP, 384}; pg8::StaticOrder S; S.init(T, QBW, G, bx); pg8::EpiQ E{WSP(bf16_t, WS_QB), WSP(float, WS_SSQ), WSP(f32x2, WS_ROPE)}; pg8::gemm_phase(lds, g, S, E, tid); }
        { PHASE_BEGIN pg8::Gemm g{WSP(bf16_t, WS_PROJ) + PC_CKV, WSP(bf16_t, WS_WUKV), T, KVW, 256, PINP, 256}; pg8::StaticOrder S; S.init(T, KVW, G, bx); pg8::EpiKV E{WSP(bf16_t, WS_KVB), WSP(float, WS_SSQ)}; pg8::gemm_phase(lds, g, S, E, tid); }
        __syncthreads();
        PHASE_BEGIN
        constexpr int KSTR = 144, KSLOT = 64 * KSTR, VSLOT = 8192;
        constexpr int L_K = 0, L_V = 6 * KSLOT, L_TB = L_V + 6 * VSLOT, L_WS = L_TB + 1024, L_ST = L_WS + NWAVES * 256;
        static_assert(L_ST + NWAVES * 4096 <= LDS_BYTES, "group A LDS");
        LAS float* tb = (LAS float*)(lds + L_TB);
        LAS float* wsf = (LAS float*)(lds + L_WS) + wave * 64;
        LAS bf16_t* stg = (LAS bf16_t*)(lds + L_ST) + wave * 2048;
        const int r32 = lane & 31, hi = lane >> 5;
        for (int ui = vcu; ui < 3072; ui += G) {
            const int br = ui >> 10, rem = ui & 1023, bh = rem >> 3, u = rem & 7, b = bh >> 3, h = bh & 7;
            const int dl = br == 0 ? 0 : (br == 1 ? 2 : 4);
            int nslots, sres[6], skt[6];
            int res, m0, sbase;
            if (br < 2) { const int rs_ = br == 0 ? 0 : (u >> 1); const int M0 = br == 0 ? 256 * u : 256 * (u & 1); nslots = 6;
#pragma unroll
                for (int s = 0; s < 6; ++s) { sres[s] = rs_; skt[s] = M0 - 128 + 64 * s; }
                res = rs_; m0 = M0 + 32 * wave; sbase = (wave >> 1); }
            else { nslots = 4;
#pragma unroll
                for (int s = 0; s < 6; ++s) { sres[s] = 2 * u + (s >> 1); skt[s] = 64 * (s & 1); }
                res = 2 * u + (wave >> 2); m0 = 32 * (wave & 3); sbase = 2 * (wave >> 2) + ((wave & 3) >> 1) - 2; }
            const size_t tokbase = (size_t)b * SEQ;
            {
                u32x4 kreg[6], vreg[6];
                const int key = tid >> 3, c = tid & 7;
#pragma unroll
                for (int s = 0; s < 6; ++s) if (s < nslots && skt[s] >= 0) {
                    const size_t tok = tokbase + (((size_t)(skt[s] + key)) << dl) + sres[s];
                    const bf16_t* p = WSP(bf16_t, WS_PROJ) + tok * PINP + h * 64 + c * 8;
                    kreg[s] = *(const u32x4*)(p + PC_KA); vreg[s] = *(const u32x4*)(p + PC_VA);
                }
                if (tid < 256) { const int st = tid - 64; float v = NEGBIG; if (st >= 0 && st <= 128) v = kp->in[I_RELB][t5_bucket(st << dl) * 8 + h] * LOG2E; tb[tid] = v; }
#pragma unroll
                for (int s = 0; s < 6; ++s) if (s < nslots && skt[s] >= 0) {
                    *(LAS u32x4*)(lds + L_K + s * KSLOT + key * KSTR + c * 16) = kreg[s];
                    *(LAS u32x4*)(lds + L_V + s * VSLOT + ((c >> 2) * 4 + (key >> 4)) * 1024 + (key & 15) * 64 + (c & 3) * 16) = vreg[s];
                }
            }
            bf16x8 qr[4];
            { const bf16_t* qp = WSP(bf16_t, WS_PROJ) + (tokbase + (((size_t)(m0 + r32)) << dl) + res) * PINP + PC_QA + h * 64 + hi * 8;
#pragma unroll
              for (int d0 = 0; d0 < 4; ++d0) qr[d0] = *(const bf16x8*)(qp + d0 * 16); }
            __syncthreads();
            float mrun = NEGBIG, lrun = 0.f; f32x16 o[2]; o[0] = f32x16{}; o[1] = f32x16{};
            const int ktl = m0 & ~63;
#pragma unroll 1
            for (int j = 0; j < 3; ++j) {
                const int kt = ktl - 64 * j; if (kt < 0) break;
                const int slot = sbase + 2 - j;
                f32x16 p0, p1;
                qk_tile<4>(p0, p1, lds + L_K + slot * KSLOT, KSTR, qr, r32, hi);
                const LAS float* tp = tb + ((m0 - kt) + r32 - 4 * hi + 64);
#pragma unroll
                for (int r = 0; r < 16; ++r) { const int cc = (r & 3) + 8 * (r >> 2); p0[r] += tp[-cc]; p1[r] += tp[-cc - 32]; }
                softmax_pv(p0, p1, mrun, lrun, o, wsf, lds + L_V + slot * VSLOT, lane, r32, hi);
            }
            bf16_t* obase = WSP(bf16_t, WS_OA) + (size_t)br * T * 512 + h * 64;
            const float lse2 = attn_finish(o, mrun, lrun, wsf, stg, lane, r32, hi, [&](int row) { return obase + (tokbase + (((size_t)(m0 + row)) << dl) + res) * 512; });
            if (hi == 0) WSP(float, WS_LSE)[((size_t)br * T + tokbase + (((size_t)(m0 + r32)) << dl) + res) * 8 + h] = lse2;
            __syncthreads();
        }
    }
    grid.sync();
    {
        PHASE_BEGIN
        constexpr int KSTR = 208, KSLOT = 64 * KSTR, VSLOT = 8192, BUF = KSLOT + VSLOT;
        constexpr int L_WS = 2 * BUF, L_ST = L_WS + NWAVES * 256;
        static_assert(L_ST + NWAVES * 4096 <= LDS_BYTES, "MLA LDS");
        LAS float* wsf = (LAS float*)(lds + L_WS) + wave * 64;
        LAS bf16_t* stg = (LAS bf16_t*)(lds + L_ST) + wave * 2048;
        const int r32 = lane & 31, hi = lane >> 5;
        for (int pi = vcu; pi < 512; pi += G)
        for (int half = 0; half < 2; ++half) {
            const int bh = pi >> 2, s4 = pi & 3, qb = half == 0 ? s4 : 7 - s4, b = bh >> 3, h = bh & 7;
            const int q0 = qb * 256, NT = (q0 + 256) / 64;
            const size_t tokbase = (size_t)b * SEQ;
            const int qrow = q0 + 32 * wave;
            bf16x8 qr[6];
            { const bf16_t* qp = WSP(bf16_t, WS_QB) + (tokbase + qrow + r32) * QBW;
#pragma unroll
              for (int d0 = 0; d0 < 4; ++d0) qr[d0] = *(const bf16x8*)(qp + h * 64 + d0 * 16 + hi * 8);
#pragma unroll
              for (int d0 = 0; d0 < 2; ++d0) qr[4 + d0] = *(const bf16x8*)(qp + 512 + h * 32 + d0 * 16 + hi * 8); }
            const int key = tid >> 3, c = tid & 7, key2 = tid >> 2, c2 = tid & 3;
            u32x4 kn, kr, vv;
#define MLA_LOAD(t) do { const size_t tk = tokbase + (size_t)(t) * 64; \
                kn = *(const u32x4*)(WSP(bf16_t, WS_KVB) + (tk + key) * KVW + h * 64 + c * 8); vv = *(const u32x4*)(WSP(bf16_t, WS_KVB) + (tk + key) * KVW + 512 + h * 64 + c * 8); \
                if (tid < 256) kr = *(const u32x4*)(WSP(bf16_t, WS_PROJ) + (tk + key2) * PINP + PC_KR + c2 * 8); } while (0)
#define MLA_STORE(buf) do { LAS unsigned char* bp = lds + (buf) * BUF; \
                *(LAS u32x4*)(bp + key * KSTR + c * 16) = kn; *(LAS u32x4*)(bp + KSLOT + ((c >> 2) * 4 + (key >> 4)) * 1024 + (key & 15) * 64 + (c & 3) * 16) = vv; \
                if (tid < 256) *(LAS u32x4*)(bp + key2 * KSTR + 128 + c2 * 16) = kr; } while (0)
            MLA_LOAD(0); MLA_STORE(0);
            __syncthreads();
            float mrun = NEGBIG, lrun = 0.f; f32x16 o[2]; o[0] = f32x16{}; o[1] = f32x16{};
#pragma unroll 1
            for (int t = 0; t < NT; ++t) {
                if (t + 1 < NT) MLA_LOAD(t + 1);
                const int kt = 64 * t;
                if (kt <= qrow + 31) {
                    LAS unsigned char* bp = lds + (t & 1) * BUF;
                    f32x16 p0, p1;
                    qk_tile<6>(p0, p1, bp, KSTR, qr, r32, hi);
                    if (kt + 63 > qrow) {
                        const int qq = qrow + r32 - kt - 4 * hi;
#pragma unroll
                        for (int r = 0; r < 16; ++r) { const int cc = (r & 3) + 8 * (r >> 2); if (cc > qq) p0[r] = NEGBIG; if (cc + 32 > qq) p1[r] = NEGBIG; }
                    }
                    softmax_pv(p0, p1, mrun, lrun, o, wsf, bp + KSLOT, lane, r32, hi);
                }
                if (t + 1 < NT) MLA_STORE((t + 1) & 1);
                __syncthreads();
            }
#undef MLA_LOAD
#undef MLA_STORE
            bf16_t* obase = WSP(bf16_t, WS_OUTB) + h * 64;
            (void)attn_finish(o, mrun, lrun, wsf, stg, lane, r32, hi, [&](int row) { return obase + (tokbase + qrow + row) * 512; });
            __syncthreads();
        }
    }
    grid.sync();
    { PHASE_BEGIN
    for (int m = gw; m < T; m += NGW) {
        const int hd = lane >> 3;
        float ls[3];
#pragma unroll
        for (int r = 0; r < 3; ++r) ls[r] = WSP(float, WS_LSE)[((size_t)r * T + m) * 8 + hd];
        const float mx = fmaxf(ls[0], fmaxf(ls[1], ls[2]));
        float e[3], es = 0.f;
#pragma unroll
        for (int r = 0; r < 3; ++r) { e[r] = __builtin_amdgcn_exp2f(ls[r] - mx); es += e[r]; }
        const float inv = 1.0f / es;
        float a[8];
#pragma unroll
        for (int j = 0; j < 8; ++j) a[j] = 0.f;
#pragma unroll
        for (int r = 0; r < 3; ++r) { const u32x4 v = *(const u32x4*)(WSP(bf16_t, WS_OA) + ((size_t)r * T + m) * 512 + lane * 8); const float w = e[r] * inv;
#pragma unroll
            for (int j = 0; j < 4; ++j) { a[2 * j] += w * __uint_as_float(v[j] << 16); a[2 * j + 1] += w * __uint_as_float(v[j] & 0xffff0000u); } }
        float bb[8];
        { const u32x4 v = *(const u32x4*)(WSP(bf16_t, WS_OUTB) + (size_t)m * 512 + lane * 8);
#pragma unroll
          for (int j = 0; j < 4; ++j) { bb[2 * j] = __uint_as_float(v[j] << 16); bb[2 * j + 1] = __uint_as_float(v[j] & 0xffff0000u); } }
        float sa = 0.f, sb = 0.f;
#pragma unroll
        for (int j = 0; j < 8; ++j) { sa += a[j] * a[j]; sb += bb[j] * bb[j]; }
        const float ra = rsqrtf(wave_sum(sa) * (1.f / 512.f) + EPS), rb = rsqrtf(wave_sum(sb) * (1.f / 512.f) + EPS);
        u32x4 wa, wb;
        wa.x = cvtpk(a[0] * ra, a[1] * ra); wa.y = cvtpk(a[2] * ra, a[3] * ra); wa.z = cvtpk(a[4] * ra, a[5] * ra); wa.w = cvtpk(a[6] * ra, a[7] * ra);
        wb.x = cvtpk(bb[0] * rb, bb[1] * rb); wb.y = cvtpk(bb[2] * rb, bb[3] * rb); wb.z = cvtpk(bb[4] * rb, bb[5] * rb); wb.w = cvtpk(bb[6] * rb, bb[7] * rb);
        *(u32x4*)(WSP(bf16_t, WS_Y) + (size_t)m * DM + lane * 8) = wa; *(u32x4*)(WSP(bf16_t, WS_Y) + (size_t)m * DM + 512 + lane * 8) = wb;
    } }
    grid.sync();
    {
        PHASE_BEGIN
        pg8::Gemm g{WSP(bf16_t, WS_Y), WSP(bf16_t, WS_WOUT), T, DM, DM, DM, DM}; pg8::StaticOrder S; S.init(T, DM, G, bx);
        pg8::EpiResGate E{kp->in[I_X], kp->out, WSP(float, WS_MOD) + 2048};
        pg8::gemm_phase(lds, g, S, E, tid);
    }
    grid.sync();
    { PHASE_BEGIN
    for (int m = gw; m < T; m += NGW) { const float* md = WSP(float, WS_MOD) + (size_t)(m >> 11) * NMOD; norm_row_bf16(kp->out + (size_t)m * DM, kp->in[I_GN2], md + 4096, md + 3072, WSP(bf16_t, WS_H) + (size_t)m * DM, lane); } }
    grid.sync();
    {
        PHASE_BEGIN
        pg8::Gemm g{WSP(bf16_t, WS_H), WSP(bf16_t, WS_WFFI), T, 2 * DFF, DM, DM, DM}; pg8::StaticOrder S; S.init(T, 2 * DFF, G, bx);
        pg8::EpiSwiglu E{WSP(bf16_t, WS_HF)};
        pg8::gemm_phase(lds, g, S, E, tid);
    }
    grid.sync();
    {
        PHASE_BEGIN
        pg8::Gemm g{WSP(bf16_t, WS_HF), WSP(bf16_t, WS_WFFO), T, DM, DFF, DFF, DFF}; pg8::StaticOrder S; S.init(T, DM, G, bx);
        pg8::EpiResGate E{kp->out, kp->out, WSP(float, WS_MOD) + 5120};
        pg8::gemm_phase(lds, g, S, E, tid);
    }
    grid.sync();
    { PHASE_BEGIN
    for (int m = gw; m < T; m += NGW) {
        f32x4* xr = (f32x4*)(kp->out + (size_t)m * DM) + lane;
        f32x4 v[4]; float s = 0.f;
#pragma unroll
        for (int j = 0; j < 4; ++j) { v[j] = xr[64 * j]; s += (v[j].x * v[j].x + v[j].y * v[j].y) + (v[j].z * v[j].z + v[j].w * v[j].w); }
        const float rstd = rsqrtf(wave_sum(s) * (1.f / DM) + EPS);
#pragma unroll
        for (int j = 0; j < 4; ++j) { const f32x4 g = *(const f32x4*)(kp->in[I_GFIN] + 4 * lane + 256 * j); xr[64 * j] = v[j] * rstd * g; }
    } }
}

extern "C" void kernel_launch(void* const* d_in, const int* in_sizes, int n_in, void* d_out, int out_size, void* d_ws, size_t ws_size, hipStream_t stream) {
    static int grid = 0;
    if (grid == 0) {
        if (n_in != 18 || out_size != T * DM || ws_size < WS_END) { fprintf(stderr, "kernel_launch: unexpected shapes (n_in %d out %d ws %zu)\n", n_in, out_size, ws_size); grid = -1; return; }
        int dev = 0, cus = 0, per_cu = 0;
        (void)hipGetDevice(&dev);
        (void)hipDeviceGetAttribute(&cus, hipDeviceAttributeMultiprocessorCount, dev);
        (void)hipFuncSetAttribute((const void*)fwd_kernel, hipFuncAttributeMaxDynamicSharedMemorySize, LDS_BYTES);
        (void)hipOccupancyMaxActiveBlocksPerMultiprocessor(&per_cu, (const void*)fwd_kernel, 512, LDS_BYTES);
        grid = (per_cu >= 1 && cus == 256) ? cus : -1;
        if (grid < 0) { fprintf(stderr, "kernel_launch: needs 256 CUs with one resident workgroup each (cus %d per_cu %d)\n", cus, per_cu); return; }
    }
    if (grid < 0) return;
    Args a{};
    for (int i = 0; i < 18; ++i) a.in[i] = (const float*)d_in[i];
    a.out = (float*)d_out; a.ws = (unsigned char*)d_ws;
    void* kargs[] = {&a};
    hipError_t e = hipLaunchCooperativeKernel((const void*)fwd_kernel, dim3(grid), dim3(512), kargs, LDS_BYTES, stream);
    if (e != hipSuccess) fprintf(stderr, "cooperative launch failed: %s\n", hipGetErrorString(e));
}
```

```cpp
#include <hip/hip_runtime.h>
#include <hip/hip_cooperative_groups.h>
#include <cstdio>
#include <cstdint>
namespace cg = cooperative_groups;

#define LAS __attribute__((address_space(3)))
typedef unsigned short bf16_t;
typedef short bf16x8 __attribute__((ext_vector_type(8)));
typedef short s16x4 __attribute__((ext_vector_type(4)));
typedef float f32x4 __attribute__((ext_vector_type(4)));
typedef float f32x2 __attribute__((ext_vector_type(2)));
typedef float f32x16 __attribute__((ext_vector_type(16)));
typedef unsigned u32x4 __attribute__((ext_vector_type(4)));
typedef unsigned u32x2 __attribute__((ext_vector_type(2)));
typedef __bf16 bf16x2_t __attribute__((ext_vector_type(2)));

constexpr int NB = 16, SEQ = 2048, DM = 1024, T = NB * SEQ;
constexpr int PINP = 2304;
constexpr int QBW = 768, KVW = 1024, DFF = 2816;
constexpr int NMOD = 6 * DM;
constexpr float EPS = 1e-6f;
constexpr float LOG2E = 1.4426950408889634f;
constexpr float C2A = 0.18033688011112042f;
constexpr float C2B = 0.14724444602590306f;
constexpr float NEGBIG = -1e30f;
constexpr int PC_QA = 0, PC_KA = 512, PC_VA = 1024, PC_CQ = 1536, PC_KR = 1920, PC_CKV = 2048;

constexpr size_t MiB = 1u << 20;
constexpr size_t WS_MOD = 0;
constexpr size_t WS_SSQ = 512 * 1024;
constexpr size_t WS_ROPE = 1 * MiB;
constexpr size_t WS_LSE = 2 * MiB;
constexpr size_t WS_BAR = 6 * MiB;
constexpr size_t WS_WIN = 8 * MiB;
constexpr size_t WS_WUQ = 13 * MiB;
constexpr size_t WS_WUKV = 14 * MiB;
constexpr size_t WS_WOUT = 15 * MiB;
constexpr size_t WS_WFFI = 17 * MiB;
constexpr size_t WS_WFFO = 28 * MiB;
constexpr size_t WS_PROJ = 40 * MiB;
constexpr size_t WS_QB = 184 * MiB;
constexpr size_t WS_HF = 40 * MiB;
constexpr size_t WS_KVB = 232 * MiB;
constexpr size_t WS_H = 296 * MiB;
constexpr size_t WS_OA = 296 * MiB;
constexpr size_t WS_OUTB = 392 * MiB;
constexpr size_t WS_Y = 424 * MiB;
constexpr size_t WS_END = 488 * MiB;

constexpr int LDS_BYTES = 147456;
constexpr int NWAVES = 8;
constexpr int MISC_OFF = LDS_BYTES - 64;

__device__ const float ROPE_INV[16] = {1.0f, 0.5623413251903491f, 0.31622776601683794f, 0.1778279410038923f, 0.1f, 0.05623413251903491f, 0.03162277660168379f,
    0.01778279410038923f, 0.01f, 0.005623413251903491f, 0.003162277660168379f, 0.001778279410038923f, 0.001f, 0.0005623413251903491f, 0.00031622776601683794f, 0.0001778279410038923f};

__device__ __forceinline__ unsigned cvtpk(float lo, float hi) { f32x2 v = {lo, hi}; bf16x2_t b = __builtin_convertvector(v, bf16x2_t); return __builtin_bit_cast(unsigned, b); }
__device__ __forceinline__ float bf2f(unsigned short h) { return __uint_as_float(((unsigned)h) << 16); }
__device__ __forceinline__ float wave_sum(float v) {
#pragma unroll
    for (int o = 1; o < 64; o <<= 1) v += __shfl_xor(v, o);
    return v;
}

namespace pg8 {
constexpr int BM = 256, BK = 64, HALF = 128, HTB = HALF * BK * 2, STAGE_BYTES = 8 * HTB, NXCD = 8, WGM = 8;
__host__ __device__ __forceinline__ int lds_byte(int r, int c) { const int st = (r >> 4) * 2 + (c >> 5), rr = r & 15, cc = c & 31, ob = rr * 64 + cc * 2; return st * 1024 + (ob ^ (((ob >> 9) & 1) << 5)); }
__host__ __device__ __forceinline__ void stage_rc(int b, int& R, int& C) { const int st = b / 1024, sb = b % 1024, swz = sb ^ (((sb >> 9) & 1) << 5); R = (st >> 1) * 16 + swz / 64; C = (st & 1) * 32 + (swz % 64) / 2; }
__host__ __device__ __forceinline__ int perm32(int rho) { const int n = rho >> 4, i = rho & 15; return 8 * (i >> 2) + 4 * n + (i & 3); }

struct Unit { int pm, pn; };
struct Gemm { const bf16_t* A; const bf16_t* Bt; int M, N, K, lda, ldb; };

struct StaticOrder {
    int nM, nN, nwg, G, c;
    __device__ void init(int M, int N, int G_, int c_) { nM = M / BM; nN = N / BM; nwg = nM * nN; G = G_; c = c_; }
    __device__ bool next(int i, Unit& u) const {
        const long L = (long)i * G + c; if (L >= nwg) return false;
        int wgid = (int)L; { const int q = nwg / NXCD, r = nwg % NXCD, xcd = wgid % NXCD, off = wgid / NXCD; wgid = (xcd < r ? xcd * (q + 1) : r * (q + 1) + (xcd - r) * q) + off; }
        const int nig = WGM * nN, gid = wgid / nig, fm = gid * WGM, gsz = (nM - fm) < WGM ? (nM - fm) : WGM;
        u.pm = fm + ((wgid % nig) % gsz); u.pn = (wgid % nig) / gsz; return true;
    }
};

template <class Epi>
__device__ __forceinline__ void gemm_phase(LAS unsigned char* lds, const Gemm g, const StaticOrder& S, const Epi& E, const int tid) {
    const int wid = __builtin_amdgcn_readfirstlane(tid >> 6), lane = tid & 63, wr = wid >> 2, wc = wid & 3, fr = lane & 15, fq = lane >> 4;
    const int K = g.K, nt = K / BK;
    unsigned voffA[2], voffB[2];
#pragma unroll
    for (int i = 0; i < 2; ++i) { int R, C; stage_rc(tid * 16 + i * 8192, R, C); const int Rb = Epi::PERM ? ((R & ~31) + perm32(R & 31)) : R;
        voffA[i] = (unsigned)(R * g.lda + C) * 2u; voffB[i] = (unsigned)(Rb * g.ldb + C) * 2u; }
    const size_t kstep = (size_t)(BK * 2);
    const size_t hstepA = (size_t)HALF * g.lda * 2, hstepB = (size_t)HALF * g.ldb * 2;
    const size_t tstepA = 2 * hstepA, tstepB = 2 * hstepB;
    const unsigned ldsw = (unsigned)wid * 1024u;
    const int aoff = lds_byte(wr * 64 + fr, fq * 8), boff = lds_byte(wc * 32 + fr, fq * 8);
#define PG8_SA(b, h) (((b) * 2 + (h)) * HTB)
#define PG8_SB(b, h) ((4 + (b) * 2 + (h)) * HTB)
#define PG8_STAGE(bufoff, gbase, voff) do { _Pragma("unroll") for (int _i = 0; _i < 2; ++_i) \
        __builtin_amdgcn_global_load_lds((const unsigned*)((const char*)(gbase) + (voff)[_i]), (LAS unsigned*)(lds + (bufoff) + ldsw + _i * 8192), 16, 0, 0); } while (0)
#define PG8_LDA(dst, b, h) do { _Pragma("unroll") for (int m = 0; m < 4; ++m) _Pragma("unroll") for (int k = 0; k < 2; ++k) dst[m][k] = *(const LAS bf16x8*)(lds + PG8_SA(b, h) + aoff + m * 2048 + k * 1024); } while (0)
#define PG8_LDB(dst, b, h) do { _Pragma("unroll") for (int n = 0; n < 2; ++n) _Pragma("unroll") for (int k = 0; k < 2; ++k) dst[n][k] = *(const LAS bf16x8*)(lds + PG8_SB(b, h) + boff + n * 2048 + k * 1024); } while (0)
#define PG8_MMA(ai, bj, At, Bt) do { __builtin_amdgcn_s_setprio(1); _Pragma("unroll") for (int m = 0; m < 4; ++m) _Pragma("unroll") for (int n = 0; n < 2; ++n) _Pragma("unroll") for (int k = 0; k < 2; ++k) \
        acc[ai][bj][m][n] = __builtin_amdgcn_mfma_f32_16x16x32_bf16(Bt[n][k], At[m][k], acc[ai][bj][m][n], 0, 0, 0); __builtin_amdgcn_s_setprio(0); } while (0)
#define PG8_WAIT_V(n) asm volatile("s_waitcnt vmcnt(" #n ")" ::: "memory")
#define PG8_WAIT_L(n) asm volatile("s_waitcnt lgkmcnt(" #n ")" ::: "memory")
#define PG8_BAR __builtin_amdgcn_s_barrier()
#define PG8_SCHED __builtin_amdgcn_sched_barrier(0)
    Unit cur, nxt; int ui = 0;
    if (!S.next(0, cur)) return;
    f32x4 acc[2][2][4][2];
#pragma unroll
    for (int a = 0; a < 2; ++a)
#pragma unroll
        for (int b = 0; b < 2; ++b)
#pragma unroll
            for (int m = 0; m < 4; ++m)
#pragma unroll
                for (int n = 0; n < 2; ++n) acc[a][b][m][n] = (f32x4){0.f, 0.f, 0.f, 0.f};
    bf16x8 At[4][2], B0[2][2], B1[2][2];
    const char* cA = (const char*)g.A + (size_t)cur.pm * tstepA; const char* cB = (const char*)g.Bt + (size_t)cur.pn * tstepB;
    PG8_STAGE(PG8_SB(0, 0), cB, voffB); PG8_STAGE(PG8_SB(0, 1), cB + hstepB, voffB); PG8_STAGE(PG8_SA(0, 0), cA, voffA); PG8_STAGE(PG8_SA(0, 1), cA + hstepA, voffA);
    if (wr == 1) PG8_BAR;
    PG8_WAIT_V(2); PG8_BAR;
    PG8_STAGE(PG8_SB(1, 0), cB + kstep, voffB); PG8_STAGE(PG8_SA(1, 0), cA + kstep, voffA); PG8_STAGE(PG8_SB(1, 1), cB + hstepB + kstep, voffB);
    PG8_WAIT_V(6); PG8_BAR;
    for (;;) {
        const bool has_next = S.next(ui + 1, nxt);
        const char* nA = has_next ? (const char*)g.A + (size_t)nxt.pm * tstepA : cA; const char* nB = has_next ? (const char*)g.Bt + (size_t)nxt.pn * tstepB : cB;
#pragma unroll 1
        for (int t = 0; t < nt; t += 2) {
            const bool last = (t == nt - 2);
            const char* a1 = cA + (size_t)(t + 1) * kstep;
            const char* a2 = last ? nA : cA + (size_t)(t + 2) * kstep; const char* b2 = last ? nB : cB + (size_t)(t + 2) * kstep;
            const char* a3 = a2 + kstep; const char* b3 = b2 + kstep;
            PG8_LDB(B0, 0, 0); PG8_LDB(B1, 0, 1); PG8_SCHED; PG8_LDA(At, 0, 0); PG8_STAGE(PG8_SA(1, 1), a1 + hstepA, voffA);
            PG8_WAIT_V(8); PG8_WAIT_L(0); PG8_BAR; PG8_MMA(0, 0, At, B0); PG8_MMA(0, 1, At, B1); PG8_BAR; PG8_SCHED;
            PG8_LDA(At, 0, 1); PG8_STAGE(PG8_SB(0, 0), b2, voffB); PG8_STAGE(PG8_SB(0, 1), b2 + hstepB, voffB); PG8_STAGE(PG8_SA(0, 0), a2, voffA);
            PG8_WAIT_V(8); PG8_WAIT_L(0); PG8_BAR; PG8_MMA(1, 0, At, B0); PG8_MMA(1, 1, At, B1); PG8_BAR; PG8_SCHED;
            PG8_LDB(B0, 1, 0); PG8_LDB(B1, 1, 1); PG8_SCHED; PG8_LDA(At, 1, 0); PG8_STAGE(PG8_SA(0, 1), a2 + hstepA, voffA);
            PG8_WAIT_V(8); PG8_WAIT_L(0); PG8_BAR; PG8_MMA(0, 0, At, B0); PG8_MMA(0, 1, At, B1); PG8_BAR; PG8_SCHED;
            PG8_LDA(At, 1, 1); PG8_STAGE(PG8_SB(1, 0), b3, voffB); PG8_STAGE(PG8_SB(1, 1), b3 + hstepB, voffB); PG8_STAGE(PG8_SA(1, 0), a3, voffA);
            PG8_WAIT_V(8); PG8_WAIT_L(0); PG8_BAR; PG8_MMA(1, 0, At, B0); PG8_MMA(1, 1, At, B1); PG8_BAR; PG8_SCHED;
        }
        if (wr == 0) PG8_BAR;
        E(acc, cur, wr, wc, fr, fq);
        if (!has_next) break;
#pragma unroll
        for (int a = 0; a < 2; ++a)
#pragma unroll
            for (int b = 0; b < 2; ++b)
#pragma unroll
                for (int m = 0; m < 4; ++m)
#pragma unroll
                    for (int n = 0; n < 2; ++n) acc[a][b][m][n] = (f32x4){0.f, 0.f, 0.f, 0.f};
        cur = nxt; cA = nA; cB = nB; ++ui;
        if (wr == 1) PG8_BAR;
    }
    PG8_WAIT_V(0);
    PG8_BAR;
#undef PG8_SA
#undef PG8_SB
#undef PG8_STAGE
#undef PG8_LDA
#undef PG8_LDB
#undef PG8_MMA
#undef PG8_WAIT_V
#undef PG8_WAIT_L
#undef PG8_BAR
#undef PG8_SCHED
}

typedef const f32x4 (&AccRef)[2][2][4][2];

struct EpiProj {
    static constexpr bool PERM = true;
    bf16_t* O; float* ssq; const f32x2* rt;
    __device__ __forceinline__ void operator()(AccRef acc, const Unit& u, int wr, int wc, int fr, int fq) const {
        const int row0 = u.pm * BM + wr * 64 + fr;
#pragma unroll
        for (int bj = 0; bj < 2; ++bj) {
            const int cgi = u.pn * 8 + bj * 4 + wc;
            const int col0 = cgi * 32 + 8 * fq;
            if (cgi >= 61 && cgi < 64) continue;
            if (cgi == 60) {
                const int ib = 8 * (fq & 1);
#pragma unroll
                for (int ai = 0; ai < 2; ++ai)
#pragma unroll
                    for (int m = 0; m < 4; ++m) {
                        const int row = row0 + ai * HALF + m * 16; const int pos = row & (SEQ - 1);
                        float o[8];
#pragma unroll
                        for (int n = 0; n < 2; ++n)
#pragma unroll
                            for (int j = 0; j < 4; ++j) { const float v = acc[ai][bj][m][n][j]; const float p = __shfl_xor(v, 32); const f32x2 cs = rt[pos * 16 + ib + 4 * n + j];
                                o[4 * n + j] = v * cs.x + (fq < 2 ? -p : p) * cs.y; }
                        u32x4 w; w.x = cvtpk(o[0], o[1]); w.y = cvtpk(o[2], o[3]); w.z = cvtpk(o[4], o[5]); w.w = cvtpk(o[6], o[7]);
                        *(u32x4*)(O + (size_t)row * PINP + col0) = w;
                    }
                continue;
            }
            const float sc = cgi < 16 ? C2A : 1.f;
            const bool stat = (cgi >= 48 && cgi < 60) || cgi >= 64;
            const int which = cgi >= 64 ? 1 : 0;
#pragma unroll
            for (int ai = 0; ai < 2; ++ai)
#pragma unroll
                for (int m = 0; m < 4; ++m) {
                    const int row = row0 + ai * HALF + m * 16;
                    const f32x4 v0 = acc[ai][bj][m][0], v1 = acc[ai][bj][m][1];
                    u32x4 w; w.x = cvtpk(v0[0] * sc, v0[1] * sc); w.y = cvtpk(v0[2] * sc, v0[3] * sc); w.z = cvtpk(v1[0] * sc, v1[1] * sc); w.w = cvtpk(v1[2] * sc, v1[3] * sc);
                    *(u32x4*)(O + (size_t)row * PINP + col0) = w;
                    if (stat) {
                        float s = (v0[0] * v0[0] + v0[1] * v0[1]) + (v0[2] * v0[2] + v0[3] * v0[3]) + (v1[0] * v1[0] + v1[1] * v1[1]) + (v1[2] * v1[2] + v1[3] * v1[3]);
                        s += __shfl_xor(s, 16); s += __shfl_xor(s, 32);
                        if (fq == 0) atomicAdd(ssq + (size_t)row * 2 + which, s);
                    }
                }
        }
    }
};
struct EpiQ {
    static constexpr bool PERM = true;
    bf16_t* O; const float* ssq; const f32x2* rt;
    __device__ __forceinline__ void operator()(AccRef acc, const Unit& u, int wr, int wc, int fr, int fq) const {
        const int row0 = u.pm * BM + wr * 64 + fr;
        float rs[2][4];
#pragma unroll
        for (int ai = 0; ai < 2; ++ai)
#pragma unroll
            for (int m = 0; m < 4; ++m) rs[ai][m] = rsqrtf(ssq[(size_t)(row0 + ai * HALF + m * 16) * 2] * (1.0f / 384.0f) + EPS) * C2B;
#pragma unroll
        for (int bj = 0; bj < 2; ++bj) {
            const int cgi = u.pn * 8 + bj * 4 + wc;
            const int col0 = cgi * 32 + 8 * fq;
            const bool rope = cgi >= 16;
            const int ib = 8 * (fq & 1);
#pragma unroll
            for (int ai = 0; ai < 2; ++ai)
#pragma unroll
                for (int m = 0; m < 4; ++m) {
                    const int row = row0 + ai * HALF + m * 16; const int pos = row & (SEQ - 1); const float r = rs[ai][m];
                    float o[8];
#pragma unroll
                    for (int n = 0; n < 2; ++n)
#pragma unroll
                        for (int j = 0; j < 4; ++j) { const float v = acc[ai][bj][m][n][j] * r;
                            if (rope) { const float p = __shfl_xor(v, 32); const f32x2 cs = rt[pos * 16 + ib + 4 * n + j]; o[4 * n + j] = v * cs.x + (fq < 2 ? -p : p) * cs.y; }
                            else o[4 * n + j] = v; }
                    u32x4 w; w.x = cvtpk(o[0], o[1]); w.y = cvtpk(o[2], o[3]); w.z = cvtpk(o[4], o[5]); w.w = cvtpk(o[6], o[7]);
                    *(u32x4*)(O + (size_t)row * QBW + col0) = w;
                }
        }
    }
};
struct EpiKV {
    static constexpr bool PERM = true;
    bf16_t* O; const float* ssq;
    __device__ __forceinline__ void operator()(AccRef acc, const Unit& u, int wr, int wc, int fr, int fq) const {
        const int row0 = u.pm * BM + wr * 64 + fr;
#pragma unroll
        for (int ai = 0; ai < 2; ++ai)
#pragma unroll
            for (int m = 0; m < 4; ++m) {
                const int row = row0 + ai * HALF + m * 16;
                const float r = rsqrtf(ssq[(size_t)row * 2 + 1] * (1.0f / 256.0f) + EPS);
#pragma unroll
                for (int bj = 0; bj < 2; ++bj) {
                    const int col0 = u.pn * BM + bj * HALF + wc * 32 + 8 * fq;
                    const f32x4 v0 = acc[ai][bj][m][0] * r, v1 = acc[ai][bj][m][1] * r;
                    u32x4 w; w.x = cvtpk(v0[0], v0[1]); w.y = cvtpk(v0[2], v0[3]); w.z = cvtpk(v1[0], v1[1]); w.w = cvtpk(v1[2], v1[3]);
                    *(u32x4*)(O + (size_t)row * KVW + col0) = w;
                }
            }
    }
};
struct EpiResGate {
    static constexpr bool PERM = false;
    const float* base; float* out; const float* gate;
    __device__ __forceinline__ void operator()(AccRef acc, const Unit& u, int wr, int wc, int fr, int fq) const {
        const int row0 = u.pm * BM + wr * 64 + fr;
        const float* gp = gate + (size_t)(u.pm >> 3) * NMOD;
#pragma unroll
        for (int bj = 0; bj < 2; ++bj)
#pragma unroll
            for (int n = 0; n < 2; ++n) {
                const int col = u.pn * BM + bj * HALF + wc * 32 + 16 * n + 4 * fq;
                const f32x4 gv = *(const f32x4*)(gp + col);
#pragma unroll
                for (int ai = 0; ai < 2; ++ai)
#pragma unroll
                    for (int m = 0; m < 4; ++m) {
                        const size_t off = (size_t)(row0 + ai * HALF + m * 16) * DM + col;
                        const f32x4 bs = *(const f32x4*)(base + off);
                        *(f32x4*)(out + off) = bs + gv * acc[ai][bj][m][n];
                    }
            }
    }
};
struct EpiSwiglu {
    static constexpr bool PERM = true;
    bf16_t* O;
    __device__ __forceinline__ void operator()(AccRef acc, const Unit& u, int wr, int wc, int fr, int fq) const {
        const int row0 = u.pm * BM + wr * 64 + fr;
        const int col0 = u.pn * HALF + wc * 32 + 8 * fq;
#pragma unroll
        for (int ai = 0; ai < 2; ++ai)
#pragma unroll
            for (int m = 0; m < 4; ++m) {
                const int row = row0 + ai * HALF + m * 16;
                float o[8];
#pragma unroll
                for (int n = 0; n < 2; ++n)
#pragma unroll
                    for (int j = 0; j < 4; ++j) { const float gte = acc[ai][0][m][n][j], up = acc[ai][1][m][n][j];
                        o[4 * n + j] = gte * __builtin_amdgcn_rcpf(1.0f + __builtin_amdgcn_exp2f(-gte * LOG2E)) * up; }
                u32x4 w; w.x = cvtpk(o[0], o[1]); w.y = cvtpk(o[2], o[3]); w.z = cvtpk(o[4], o[5]); w.w = cvtpk(o[6], o[7]);
                *(u32x4*)(O + (size_t)row * DFF + col0) = w;
            }
    }
};
}

typedef LAS const unsigned char* lds_cptr;
__device__ __forceinline__ int crow(int r, int hi) { return (r & 3) + 8 * (r >> 2) + 4 * hi; }
__device__ __forceinline__ s16x4 vtr(lds_cptr p) { typedef short v4i16_t __attribute__((ext_vector_type(4))); return __builtin_bit_cast(s16x4, __builtin_amdgcn_ds_read_tr16_b64_v4i16((LAS v4i16_t*)p)); }
__device__ __forceinline__ float swapmax(float m) { auto rr = __builtin_amdgcn_permlane32_swap(__float_as_uint(m), __float_as_uint(m), false, false); return fmaxf(__uint_as_float(rr[0]), __uint_as_float(rr[1])); }
__device__ __forceinline__ float swapsum(float m) { auto rr = __builtin_amdgcn_permlane32_swap(__float_as_uint(m), __float_as_uint(m), false, false); return __uint_as_float(rr[0]) + __uint_as_float(rr[1]); }

template <int ND>
__device__ __forceinline__ void qk_tile(f32x16& p0, f32x16& p1, lds_cptr kslot, int kstride, const bf16x8* qr, int r32, int hi) {
    lds_cptr kb = kslot + r32 * kstride + hi * 16;
    p0 = f32x16{}; p1 = f32x16{};
#pragma unroll
    for (int d0 = 0; d0 < ND; ++d0) {
        const bf16x8 b0 = *(const LAS bf16x8*)(kb + d0 * 32);
        const bf16x8 b1 = *(const LAS bf16x8*)(kb + 32 * kstride + d0 * 32);
        p0 = __builtin_amdgcn_mfma_f32_32x32x16_bf16(b0, qr[d0], p0, 0, 0, 0);
        p1 = __builtin_amdgcn_mfma_f32_32x32x16_bf16(b1, qr[d0], p1, 0, 0, 0);
    }
}
__device__ __forceinline__ void softmax_pv(f32x16& p0, f32x16& p1, float& mrun, float& lrun, f32x16 (&o)[2], LAS float* wsf, lds_cptr vslot, int lane, int r32, int hi) {
    float a = fmaxf(p0[0], p1[0]);
#pragma unroll
    for (int r = 1; r < 16; ++r) a = fmaxf(a, fmaxf(p0[r], p1[r]));
    const float rm = swapmax(a);
    const float mn = fmaxf(mrun, rm);
    const float f = __builtin_amdgcn_exp2f(mrun - mn);
    mrun = mn;
    float s = 0.f;
#pragma unroll
    for (int r = 0; r < 16; ++r) { p0[r] = __builtin_amdgcn_exp2f(p0[r] - mn); p1[r] = __builtin_amdgcn_exp2f(p1[r] - mn); s += p0[r] + p1[r]; }
    lrun = lrun * f + s;
    if (hi == 0) wsf[r32] = f;
    asm volatile("s_waitcnt lgkmcnt(0)" ::: "memory");
#pragma unroll
    for (int r = 0; r < 16; ++r) { const float fr_ = wsf[crow(r, hi)]; o[0][r] *= fr_; o[1][r] *= fr_; }
    asm volatile("s_waitcnt lgkmcnt(0)" ::: "memory");
    u32x4 pw[4];
    pw[0] = (u32x4){cvtpk(p0[0], p0[1]), cvtpk(p0[2], p0[3]), cvtpk(p0[4], p0[5]), cvtpk(p0[6], p0[7])};
    pw[1] = (u32x4){cvtpk(p0[8], p0[9]), cvtpk(p0[10], p0[11]), cvtpk(p0[12], p0[13]), cvtpk(p0[14], p0[15])};
    pw[2] = (u32x4){cvtpk(p1[0], p1[1]), cvtpk(p1[2], p1[3]), cvtpk(p1[4], p1[5]), cvtpk(p1[6], p1[7])};
    pw[3] = (u32x4){cvtpk(p1[8], p1[9]), cvtpk(p1[10], p1[11]), cvtpk(p1[12], p1[13]), cvtpk(p1[14], p1[15])};
    lds_cptr vp = vslot + ((lane >> 4) & 1) * 32 + (lane & 3) * 8 + (4 * hi + ((lane & 15) >> 2)) * 64;
#pragma unroll
    for (int d0 = 0; d0 < 2; ++d0)
#pragma unroll
        for (int ks = 0; ks < 4; ++ks) {
            const s16x4 lo = vtr(vp + d0 * 4096 + ks * 1024), hh = vtr(vp + d0 * 4096 + ks * 1024 + 512);
            const bf16x8 vb = (bf16x8){lo[0], lo[1], lo[2], lo[3], hh[0], hh[1], hh[2], hh[3]};
            o[d0] = __builtin_amdgcn_mfma_f32_32x32x16_bf16(__builtin_bit_cast(bf16x8, pw[ks]), vb, o[d0], 0, 0, 0);
        }
}
template <class RowPtr>
__device__ __forceinline__ float attn_finish(f32x16 (&o)[2], float mrun, float lrun, LAS float* wsf, LAS bf16_t* stg, int lane, int r32, int hi, const RowPtr& rowptr) {
    const float lt = swapsum(lrun);
    asm volatile("s_waitcnt lgkmcnt(0)" ::: "memory");
    if (hi == 0) wsf[32 + r32] = lt;
    asm volatile("s_waitcnt lgkmcnt(0)" ::: "memory");
#pragma unroll
    for (int r = 0; r < 16; ++r) { const int orow = crow(r, hi); const float rl = __builtin_amdgcn_rcpf(wsf[32 + orow]);
#pragma unroll
        for (int d0 = 0; d0 < 2; ++d0) stg[orow * 64 + d0 * 32 + r32] = (bf16_t)(cvtpk(o[d0][r] * rl, 0.f) & 0xffffu); }
    asm volatile("s_waitcnt lgkmcnt(0)" ::: "memory");
#pragma unroll
    for (int i = 0; i < 4; ++i) { const int row = i * 8 + (lane >> 3), ch = lane & 7; const u32x4 v = *(const LAS u32x4*)(stg + row * 64 + ch * 8); *(u32x4*)(rowptr(row) + ch * 8) = v; }
    asm volatile("s_waitcnt lgkmcnt(0)" ::: "memory");
    return mrun + __log2f(lt);
}

struct Args { const float* in[18]; float* out; unsigned char* ws; };
enum { I_X = 0, I_C, I_WADA, I_BADA, I_GN1, I_WIN, I_GCQ, I_WUQ, I_GCKV, I_WUKV, I_RELB, I_GOA, I_GOB, I_WOUT, I_GN2, I_WFFI, I_WFFO, I_GFIN };

__device__ __forceinline__ void tr_item(const float* W, int N, int k0, int n0src, const float* ksc, bf16_t* WT, int K, int drow0, LAS float* scr, int lane) {
#pragma unroll 8
    for (int i = 0; i < 32; ++i) { const int kk = 2 * i + (lane >> 5); float v = 0.f; if (n0src >= 0) v = W[(size_t)(k0 + kk) * N + n0src + (lane & 31)]; if (ksc) v *= ksc[k0 + kk]; scr[kk * 33 + (lane & 31)] = v; }
    asm volatile("s_waitcnt lgkmcnt(0)" ::: "memory");
    const int c = lane & 7;
#pragma unroll
    for (int j = 0; j < 4; ++j) { const int n = (lane >> 3) + 8 * j; const LAS float* s = scr + (8 * c) * 33 + n;
        u32x4 o; o.x = cvtpk(s[0 * 33], s[1 * 33]); o.y = cvtpk(s[2 * 33], s[3 * 33]); o.z = cvtpk(s[4 * 33], s[5 * 33]); o.w = cvtpk(s[6 * 33], s[7 * 33]);
        *(u32x4*)(WT + (size_t)(drow0 + n) * K + k0 + 8 * c) = o; }
    asm volatile("s_waitcnt lgkmcnt(0)" ::: "memory");
}

__device__ __forceinline__ void norm_row_bf16(const float* xrow, const float* gain, const float* sc, const float* sh, bf16_t* orow, int lane) {
    const f32x4* xr = (const f32x4*)xrow + lane;
    f32x4 v[4]; float s = 0.f;
#pragma unroll
    for (int j = 0; j < 4; ++j) { v[j] = xr[64 * j]; s += (v[j].x * v[j].x + v[j].y * v[j].y) + (v[j].z * v[j].z + v[j].w * v[j].w); }
    const float rstd = rsqrtf(wave_sum(s) * (1.f / DM) + EPS);
#pragma unroll
    for (int j = 0; j < 4; ++j) {
        const int col = 4 * lane + 256 * j;
        const f32x4 g = *(const f32x4*)(gain + col), a = *(const f32x4*)(sc + col), b = *(const f32x4*)(sh + col);
        const f32x4 y = v[j] * rstd * g * (a + 1.0f) + b;
        u32x2 w; w.x = cvtpk(y.x, y.y); w.y = cvtpk(y.z, y.w);
        *(u32x2*)(orow + col) = w;
    }
}

__device__ __forceinline__ int t5_bucket(int d) {
    if (d < 16) return d;
    int b = 16;
    b += (d >= 22); b += (d >= 30); b += (d >= 40); b += (d >= 54); b += (d >= 73); b += (d >= 99); b += (d >= 134); b += (d >= 182);
    b += (d >= 246); b += (d >= 332); b += (d >= 450); b += (d >= 609); b += (d >= 825); b += (d >= 1117); b += (d >= 1513);
    return b;
}


#define XB_TMO      128
#define XB_XCNT(j)  (256  + 64 * (j))
#define XB_XSUB(j)  (1280 + 64 * (j))
#define XB_XGEN(j)  (2304 + 64 * (j))
#define XB_TOP      3328
#define XB_TOPGEN   3392
#define XCD_BAR_WORDS 3456
#define XB_SPIN_CAP (1u << 20)
__device__ __forceinline__ unsigned xb_ld(unsigned* p)              { return __hip_atomic_load(p, __ATOMIC_RELAXED, __HIP_MEMORY_SCOPE_AGENT); }
__device__ __forceinline__ unsigned xb_add(unsigned* p, unsigned v) { return __hip_atomic_fetch_add(p, v, __ATOMIC_RELAXED, __HIP_MEMORY_SCOPE_AGENT); }
__device__ __forceinline__ unsigned xb_xcc_id() { return (unsigned)__builtin_amdgcn_s_getreg((3 << 11) | 20) & 0xFu; }
#define XB_SPIN(cond, bar) do { unsigned _sp = 0; while (cond) { __builtin_amdgcn_s_sleep(1); \
    if ((++_sp & 255u) == 0u) { if (xb_ld(&(bar)[XB_TMO])) break; if (_sp > XB_SPIN_CAP) { atomicAdd(&(bar)[XB_TMO], 1u); break; } } } } while (0)
__device__ __forceinline__ void xcd_barrier_complete(unsigned* bar, unsigned x, unsigned& nloc, unsigned& nx) {
    const unsigned G = gridDim.x;
    unsigned sum, cnt, mine, sp = 0u;
    for (;;) {
        sum = 0u; cnt = 0u; mine = 0u;
#pragma unroll
        for (unsigned j = 0; j < 16; ++j) { const unsigned c = xb_ld(&bar[XB_XCNT(j)]); sum += c; cnt += (c > 0u) ? 1u : 0u; mine = (j == x) ? c : mine; }
        if (sum == G) break;
        __builtin_amdgcn_s_sleep(1);
        if ((++sp & 255u) == 0u) { if (xb_ld(&bar[XB_TMO])) break; if (sp > XB_SPIN_CAP) { atomicAdd(&bar[XB_TMO], 1u); break; } }
    }
    nloc = mine > 0u ? mine : 1u; nx = cnt > 0u ? cnt : 1u;
}
__device__ __forceinline__ void xcd_barrier(unsigned* bar, volatile LAS unsigned* st) {
    asm volatile("s_waitcnt vmcnt(0)" ::: "memory");
    __syncthreads();
    if (threadIdx.x == 0) {
        __builtin_amdgcn_s_waitcnt(0);
        const unsigned x = xb_xcc_id();
        unsigned nloc = st[0], nx = st[1];
        if (nloc == 0u) { xcd_barrier_complete(bar, x, nloc, nx); st[0] = nloc; st[1] = nx; }
        const unsigned old = xb_add(&bar[XB_XSUB(x)], 1u);
        const unsigned gen = old / nloc;
        if (old + 1u == (gen + 1u) * nloc) {
            __builtin_amdgcn_fence(__ATOMIC_RELEASE, "agent");
            asm volatile("s_waitcnt vmcnt(0)" ::: "memory");
            const unsigned og = xb_add(&bar[XB_TOP], 1u);
            const unsigned tg = og / nx;
            if (og + 1u == (tg + 1u) * nx) xb_add(&bar[XB_TOPGEN], 1u);
            else XB_SPIN(xb_ld(&bar[XB_TOPGEN]) == tg, bar);
            __builtin_amdgcn_fence(__ATOMIC_ACQUIRE, "agent");
            xb_add(&bar[XB_XGEN(x)], 1u);
            asm volatile("s_waitcnt vmcnt(0)" ::: "memory");
        } else {
            XB_SPIN(xb_ld(&bar[XB_XGEN(x)]) == gen, bar);
            __builtin_amdgcn_fence(__ATOMIC_ACQUIRE, "agent");
            asm volatile("s_waitcnt vmcnt(0)" ::: "memory");
        }
    }
    __syncthreads();
}

typedef const __attribute__((address_space(4))) Args KArgs;
__device__ __forceinline__ const KArgs* opaque_kargs() {
    const unsigned long long v = (unsigned long long)__builtin_amdgcn_kernarg_segment_ptr();
    unsigned lo = (unsigned)v, hi = (unsigned)(v >> 32); asm volatile("" : "+v"(lo), "+v"(hi));
    lo = __builtin_amdgcn_readfirstlane(lo); hi = __builtin_amdgcn_readfirstlane(hi);
    return (const KArgs*)(((unsigned long long)hi << 32) | lo);
}
#define PHASE_BEGIN \
    int tid = threadIdx.x; asm volatile("" : "+v"(tid)); \
    const int lane = tid & 63, wave = __builtin_amdgcn_readfirstlane(tid >> 6); \
    const KArgs* kp = opaque_kargs(); \
    unsigned char* ws = kp->ws; \
    const int G = gridDim.x, bx = blockIdx.x; \
    const int vcu = (bx % 8) * (G / 8) + bx / 8; \
    const int gw = vcu * NWAVES + wave, NGW = G * NWAVES; \
    (void)lane; (void)gw; (void)NGW; (void)ws; (void)vcu;
#define WSP(type, off) ((type*)(ws + (off)))

__global__ void __launch_bounds__(512, 2) fwd_kernel(Args args_unused) {
    extern __shared__ __attribute__((aligned(16))) unsigned char lds_raw[];
    LAS unsigned char* lds = (LAS unsigned char*)lds_raw;
    if (threadIdx.x == 0) { volatile LAS unsigned* st = (volatile LAS unsigned*)(lds + MISC_OFF); st[0] = 0u; st[1] = 0u;
        const KArgs* kp0 = (const KArgs*)__builtin_amdgcn_kernarg_segment_ptr(); (void)xb_add((unsigned*)(kp0->ws + WS_BAR) + XB_XCNT(xb_xcc_id()), 1u); }
    __syncthreads();
#define GRID_SYNC() do { const KArgs* kpb = (const KArgs*)__builtin_amdgcn_kernarg_segment_ptr(); \
        xcd_barrier((unsigned*)(kpb->ws + WS_BAR), (volatile LAS unsigned*)(lds + MISC_OFF)); } while (0)

    {
        PHASE_BEGIN
        for (int i = bx * 512 + tid; i < T * 2; i += G * 512) WSP(float, WS_SSQ)[i] = 0.f;
        for (int i = bx * 512 + tid; i < SEQ * 16; i += G * 512) {
            const int pos = i >> 4, k = i & 15;
            const float ang = (float)pos * ROPE_INV[k];
            const double rev = (double)ang * 0.15915494309189535;
            const float fr_ = (float)(rev - __builtin_rint(rev));
            WSP(f32x2, WS_ROPE)[i] = (f32x2){__builtin_amdgcn_cosf(fr_), __builtin_amdgcn_sinf(fr_)};
        }
        if (bx < NMOD / 32) {
            LAS float* sl = (LAS float*)lds;
            LAS float* red = (LAS float*)(lds + 65536);
            const float* c = kp->in[I_C];
            for (int i = tid; i < NB * DM; i += 512) { const float v = c[i]; sl[i] = v / (1.0f + __expf(-v)); }
            __syncthreads();
            const int col = tid & 31, ks = tid >> 5;
            const float* wp = kp->in[I_WADA] + (size_t)(ks * 64) * NMOD + bx * 32 + col;
            float acc[16];
#pragma unroll
            for (int b = 0; b < 16; ++b) acc[b] = 0.f;
#pragma unroll 4
            for (int kk = 0; kk < 64; ++kk) { const float w = wp[(size_t)kk * NMOD];
#pragma unroll
                for (int b = 0; b < 16; ++b) acc[b] += sl[b * DM + ks * 64 + kk] * w; }
#pragma unroll
            for (int b = 0; b < 16; ++b) red[(ks * 16 + b) * 32 + col] = acc[b];
            __syncthreads();
            { const int b = tid >> 5; float s = 0.f;
#pragma unroll
              for (int k2 = 0; k2 < 16; ++k2) s += red[(k2 * 16 + b) * 32 + col];
              WSP(float, WS_MOD)[b * NMOD + bx * 32 + col] = s + kp->in[I_BADA][bx * 32 + col]; }
            __syncthreads();
        }
        LAS float* scr = (LAS float*)(lds + wave * 16384);
        constexpr int IT_IN = 16 * 72, IT_UQ = 6 * 24, IT_UKV = 4 * 32, IT_OUT = 16 * 32, IT_FFI = 16 * 176, IT_FFO = 44 * 32;
        constexpr int NITEMS = IT_IN + IT_UQ + IT_UKV + IT_OUT + IT_FFI + IT_FFO;
        for (int it = gw; it < NITEMS; it += NGW) {
            int r = it;
            if (r < IT_IN) { const int kb = r / 72, nb = r % 72; const int src = nb < 60 ? 32 * nb : (nb == 60 ? 2176 : (nb < 64 ? -1 : 1920 + 32 * (nb - 64)));
                tr_item(kp->in[I_WIN], 2208, 64 * kb, src, nullptr, WSP(bf16_t, WS_WIN), 1024, 32 * nb, scr, lane); continue; } r -= IT_IN;
            if (r < IT_UQ) { const int kb = r / 24, nb = r % 24; const int src = nb < 16 ? (nb >> 1) * 96 + (nb & 1) * 32 : (nb - 16) * 96 + 64;
                tr_item(kp->in[I_WUQ], 768, 64 * kb, src, kp->in[I_GCQ], WSP(bf16_t, WS_WUQ), 384, 32 * nb, scr, lane); continue; } r -= IT_UQ;
            if (r < IT_UKV) { const int kb = r / 32, nb = r % 32; const int src = nb < 16 ? (nb >> 1) * 128 + (nb & 1) * 32 : ((nb - 16) >> 1) * 128 + 64 + (nb & 1) * 32;
                tr_item(kp->in[I_WUKV], 1024, 64 * kb, src, kp->in[I_GCKV], WSP(bf16_t, WS_WUKV), 256, 32 * nb, scr, lane); continue; } r -= IT_UKV;
            if (r < IT_OUT) { const int kb = r / 32, nb = r % 32; const float* ks_ = kb < 8 ? kp->in[I_GOA] : kp->in[I_GOB] - 512;
                tr_item(kp->in[I_WOUT], 1024, 64 * kb, 32 * nb, ks_, WSP(bf16_t, WS_WOUT), 1024, 32 * nb, scr, lane); continue; } r -= IT_OUT;
            if (r < IT_FFI) { const int kb = r / 176, nb = r % 176; const int pn = nb >> 3, w = nb & 7; const int src = w < 4 ? 128 * pn + 32 * w : DFF + 128 * pn + 32 * (w - 4);
                tr_item(kp->in[I_WFFI], 2 * DFF, 64 * kb, src, nullptr, WSP(bf16_t, WS_WFFI), 1024, 32 * nb, scr, lane); continue; } r -= IT_FFI;
            { const int kb = r / 32, nb = r % 32; tr_item(kp->in[I_WFFO], 1024, 64 * kb, 32 * nb, nullptr, WSP(bf16_t, WS_WFFO), DFF, 32 * nb, scr, lane); }
        }
    }
    GRID_SYNC();
    { PHASE_BEGIN
    for (int m = gw; m < T; m += NGW) { const float* md = WSP(float, WS_MOD) + (size_t)(m >> 11) * NMOD; norm_row_bf16(kp->in[I_X] + (size_t)m * DM, kp->in[I_GN1], md + 1024, md, WSP(bf16_t, WS_H) + (size_t)m * DM, lane); } }
    GRID_SYNC();
    {
        PHASE_BEGIN
        pg8::Gemm g{WSP(bf16_t, WS_H), WSP(bf16_t, WS_WIN), T, PINP, DM, DM, DM}; pg8::StaticOrder S; S.init(T, PINP, G, bx);
        pg8::EpiProj E{WSP(bf16_t, WS_PROJ), WSP(float, WS_SSQ), WSP(f32x2, WS_ROPE)};
        pg8::gemm_phase(lds, g, S, E, tid);
    }
    GRID_SYNC();
    {
        { PHASE_BEGIN pg8::Gemm g{WSP(bf16_t, WS_PROJ) + PC_CQ, WSP(bf16_t, WS_WUQ), T, QBW, 384, PINP, 384}; pg8::StaticOrder S; S.init(T, QBW, G, bx); pg8::EpiQ E{WSP(bf16_t, WS_QB), WSP(float, WS_SSQ), WSP(f32x2, WS_ROPE)}; pg8::gemm_phase(lds, g, S, E, tid); }
        { PHASE_BEGIN pg8::Gemm g{WSP(bf16_t, WS_PROJ) + PC_CKV, WSP(bf16_t, WS_WUKV), T, KVW, 256, PINP, 256}; pg8::StaticOrder S; S.init(T, KVW, G, bx); pg8::EpiKV E{WSP(bf16_t, WS_KVB), WSP(float, WS_SSQ)}; pg8::gemm_phase(lds, g, S, E, tid); }
        __syncthreads();
        PHASE_BEGIN
        constexpr int KSTR = 144, KSLOT = 64 * KSTR, VSLOT = 8192;
        constexpr int L_K = 0, L_V = 6 * KSLOT, L_TB = L_V + 6 * VSLOT, L_WS = L_TB + 1024, L_ST = L_WS + NWAVES * 256;
        static_assert(L_ST + NWAVES * 4096 <= LDS_BYTES, "group A LDS");
        LAS float* tb = (LAS float*)(lds + L_TB);
        LAS float* wsf = (LAS float*)(lds + L_WS) + wave * 64;
        LAS bf16_t* stg = (LAS bf16_t*)(lds + L_ST) + wave * 2048;
        const int r32 = lane & 31, hi = lane >> 5;
        for (int ui = vcu; ui < 3072; ui += G) {
            const int br = ui >> 10, rem = ui & 1023, bh = rem >> 3, u = rem & 7, b = bh >> 3, h = bh & 7;
            const int dl = br == 0 ? 0 : (br == 1 ? 2 : 4);
            int nslots, sres[6], skt[6];
            int res, m0, sbase;
            if (br < 2) { const int rs_ = br == 0 ? 0 : (u >> 1); const int M0 = br == 0 ? 256 * u : 256 * (u & 1); nslots = 6;
#pragma unroll
                for (int s = 0; s < 6; ++s) { sres[s] = rs_; skt[s] = M0 - 128 + 64 * s; }
                res = rs_; m0 = M0 + 32 * wave; sbase = (wave >> 1); }
            else { nslots = 4;
#pragma unroll
                for (int s = 0; s < 6; ++s) { sres[s] = 2 * u + (s >> 1); skt[s] = 64 * (s & 1); }
                res = 2 * u + (wave >> 2); m0 = 32 * (wave & 3); sbase = 2 * (wave >> 2) + ((wave & 3) >> 1) - 2; }
            const size_t tokbase = (size_t)b * SEQ;
            {
                u32x4 kreg[6], vreg[6];
                const int key = tid >> 3, c = tid & 7;
#pragma unroll
                for (int s = 0; s < 6; ++s) if (s < nslots && skt[s] >= 0) {
                    const size_t tok = tokbase + (((size_t)(skt[s] + key)) << dl) + sres[s];
                    const bf16_t* p = WSP(bf16_t, WS_PROJ) + tok * PINP + h * 64 + c * 8;
                    kreg[s] = *(const u32x4*)(p + PC_KA); vreg[s] = *(const u32x4*)(p + PC_VA);
                }
                if (tid < 256) { const int st = tid - 64; float v = NEGBIG; if (st >= 0 && st <= 128) v = kp->in[I_RELB][t5_bucket(st << dl) * 8 + h] * LOG2E; tb[tid] = v; }
#pragma unroll
                for (int s = 0; s < 6; ++s) if (s < nslots && skt[s] >= 0) {
                    *(LAS u32x4*)(lds + L_K + s * KSLOT + key * KSTR + c * 16) = kreg[s];
                    *(LAS u32x4*)(lds + L_V + s * VSLOT + ((c >> 2) * 4 + (key >> 4)) * 1024 + (key & 15) * 64 + (c & 3) * 16) = vreg[s];
                }
            }
            bf16x8 qr[4];
            { const bf16_t* qp = WSP(bf16_t, WS_PROJ) + (tokbase + (((size_t)(m0 + r32)) << dl) + res) * PINP + PC_QA + h * 64 + hi * 8;
#pragma unroll
              for (int d0 = 0; d0 < 4; ++d0) qr[d0] = *(const bf16x8*)(qp + d0 * 16); }
            __syncthreads();
            float mrun = NEGBIG, lrun = 0.f; f32x16 o[2]; o[0] = f32x16{}; o[1] = f32x16{};
            const int ktl = m0 & ~63;
#pragma unroll 1
            for (int j = 0; j < 3; ++j) {
                const int kt = ktl - 64 * j; if (kt < 0) break;
                const int slot = sbase + 2 - j;
                f32x16 p0, p1;
                qk_tile<4>(p0, p1, lds + L_K + slot * KSLOT, KSTR, qr, r32, hi);
                const LAS float* tp = tb + ((m0 - kt) + r32 - 4 * hi + 64);
#pragma unroll
                for (int r = 0; r < 16; ++r) { const int cc = (r & 3) + 8 * (r >> 2); p0[r] += tp[-cc]; p1[r] += tp[-cc - 32]; }
                softmax_pv(p0, p1, mrun, lrun, o, wsf, lds + L_V + slot * VSLOT, lane, r32, hi);
            }
            bf16_t* obase = WSP(bf16_t, WS_OA) + (size_t)br * T * 512 + h * 64;
            const float lse2 = attn_finish(o, mrun, lrun, wsf, stg, lane, r32, hi, [&](int row) { return obase + (tokbase + (((size_t)(m0 + row)) << dl) + res) * 512; });
            if (hi == 0) WSP(float, WS_LSE)[((size_t)br * T + tokbase + (((size_t)(m0 + r32)) << dl) + res) * 8 + h] = lse2;
            __syncthreads();
        }
    }
    GRID_SYNC();
    {
        PHASE_BEGIN
        constexpr int KSTR = 208, KSLOT = 64 * KSTR, VSLOT = 8192, BUF = KSLOT + VSLOT;
        constexpr int L_WS = 2 * BUF, L_ST = L_WS + NWAVES * 256;
        static_assert(L_ST + NWAVES * 4096 <= LDS_BYTES, "MLA LDS");
        LAS float* wsf = (LAS float*)(lds + L_WS) + wave * 64;
        LAS bf16_t* stg = (LAS bf16_t*)(lds + L_ST) + wave * 2048;
        const int r32 = lane & 31, hi = lane >> 5;
        for (int pi = vcu; pi < 512; pi += G)
        for (int half = 0; half < 2; ++half) {
            const int bh = pi >> 2, s4 = pi & 3, qb = half == 0 ? s4 : 7 - s4, b = bh >> 3, h = bh & 7;
            const int q0 = qb * 256, NT = (q0 + 256) / 64;
            const size_t tokbase = (size_t)b * SEQ;
            const int qrow = q0 + 32 * wave;
            bf16x8 qr[6];
            { const bf16_t* qp = WSP(bf16_t, WS_QB) + (tokbase + qrow + r32) * QBW;
#pragma unroll
              for (int d0 = 0; d0 < 4; ++d0) qr[d0] = *(const bf16x8*)(qp + h * 64 + d0 * 16 + hi * 8);
#pragma unroll
              for (int d0 = 0; d0 < 2; ++d0) qr[4 + d0] = *(const bf16x8*)(qp + 512 + h * 32 + d0 * 16 + hi * 8); }
            const int key = tid >> 3, c = tid & 7, key2 = tid >> 2, c2 = tid & 3;
            u32x4 kn, kr, vv;
#define MLA_LOAD(t) do { const size_t tk = tokbase + (size_t)(t) * 64; \
                kn = *(const u32x4*)(WSP(bf16_t, WS_KVB) + (tk + key) * KVW + h * 64 + c * 8); vv = *(const u32x4*)(WSP(bf16_t, WS_KVB) + (tk + key) * KVW + 512 + h * 64 + c * 8); \
                if (tid < 256) kr = *(const u32x4*)(WSP(bf16_t, WS_PROJ) + (tk + key2) * PINP + PC_KR + c2 * 8); } while (0)
#define MLA_STORE(buf) do { LAS unsigned char* bp = lds + (buf) * BUF; \
                *(LAS u32x4*)(bp + key * KSTR + c * 16) = kn; *(LAS u32x4*)(bp + KSLOT + ((c >> 2) * 4 + (key >> 4)) * 1024 + (key & 15) * 64 + (c & 3) * 16) = vv; \
                if (tid < 256) *(LAS u32x4*)(bp + key2 * KSTR + 128 + c2 * 16) = kr; } while (0)
            MLA_LOAD(0); MLA_STORE(0);
            __syncthreads();
            float mrun = NEGBIG, lrun = 0.f; f32x16 o[2]; o[0] = f32x16{}; o[1] = f32x16{};
#pragma unroll 1
            for (int t = 0; t < NT; ++t) {
                if (t + 1 < NT) MLA_LOAD(t + 1);
                const int kt = 64 * t;
                if (kt <= qrow + 31) {
                    LAS unsigned char* bp = lds + (t & 1) * BUF;
                    f32x16 p0, p1;
                    qk_tile<6>(p0, p1, bp, KSTR, qr, r32, hi);
                    if (kt + 63 > qrow) {
                        const int qq = qrow + r32 - kt - 4 * hi;
#pragma unroll
                        for (int r = 0; r < 16; ++r) { const int cc = (r & 3) + 8 * (r >> 2); if (cc > qq) p0[r] = NEGBIG; if (cc + 32 > qq) p1[r] = NEGBIG; }
                    }
                    softmax_pv(p0, p1, mrun, lrun, o, wsf, bp + KSLOT, lane, r32, hi);
                }
                if (t + 1 < NT) MLA_STORE((t + 1) & 1);
                __syncthreads();
            }
#undef MLA_LOAD
#undef MLA_STORE
            bf16_t* obase = WSP(bf16_t, WS_OUTB) + h * 64;
            (void)attn_finish(o, mrun, lrun, wsf, stg, lane, r32, hi, [&](int row) { return obase + (tokbase + qrow + row) * 512; });
            __syncthreads();
        }
    }
    GRID_SYNC();
    { PHASE_BEGIN
    for (int m = gw; m < T; m += NGW) {
        const int hd = lane >> 3;
        float ls[3];
#pragma unroll
        for (int r = 0; r < 3; ++r) ls[r] = WSP(float, WS_LSE)[((size_t)r * T + m) * 8 + hd];
        const float mx = fmaxf(ls[0], fmaxf(ls[1], ls[2]));
        float e[3], es = 0.f;
#pragma unroll
        for (int r = 0; r < 3; ++r) { e[r] = __builtin_amdgcn_exp2f(ls[r] - mx); es += e[r]; }
        const float inv = 1.0f / es;
        float a[8];
#pragma unroll
        for (int j = 0; j < 8; ++j) a[j] = 0.f;
#pragma unroll
        for (int r = 0; r < 3; ++r) { const u32x4 v = *(const u32x4*)(WSP(bf16_t, WS_OA) + ((size_t)r * T + m) * 512 + lane * 8); const float w = e[r] * inv;
#pragma unroll
            for (int j = 0; j < 4; ++j) { a[2 * j] += w * __uint_as_float(v[j] << 16); a[2 * j + 1] += w * __uint_as_float(v[j] & 0xffff0000u); } }
        float bb[8];
        { const u32x4 v = *(const u32x4*)(WSP(bf16_t, WS_OUTB) + (size_t)m * 512 + lane * 8);
#pragma unroll
          for (int j = 0; j < 4; ++j) { bb[2 * j] = __uint_as_float(v[j] << 16); bb[2 * j + 1] = __uint_as_float(v[j] & 0xffff0000u); } }
        float sa = 0.f, sb = 0.f;
#pragma unroll
        for (int j = 0; j < 8; ++j) { sa += a[j] * a[j]; sb += bb[j] * bb[j]; }
        const float ra = rsqrtf(wave_sum(sa) * (1.f / 512.f) + EPS), rb = rsqrtf(wave_sum(sb) * (1.f / 512.f) + EPS);
        u32x4 wa, wb;
        wa.x = cvtpk(a[0] * ra, a[1] * ra); wa.y = cvtpk(a[2] * ra, a[3] * ra); wa.z = cvtpk(a[4] * ra, a[5] * ra); wa.w = cvtpk(a[6] * ra, a[7] * ra);
        wb.x = cvtpk(bb[0] * rb, bb[1] * rb); wb.y = cvtpk(bb[2] * rb, bb[3] * rb); wb.z = cvtpk(bb[4] * rb, bb[5] * rb); wb.w = cvtpk(bb[6] * rb, bb[7] * rb);
        *(u32x4*)(WSP(bf16_t, WS_Y) + (size_t)m * DM + lane * 8) = wa; *(u32x4*)(WSP(bf16_t, WS_Y) + (size_t)m * DM + 512 + lane * 8) = wb;
    } }
    GRID_SYNC();
    {
        PHASE_BEGIN
        pg8::Gemm g{WSP(bf16_t, WS_Y), WSP(bf16_t, WS_WOUT), T, DM, DM, DM, DM}; pg8::StaticOrder S; S.init(T, DM, G, bx);
        pg8::EpiResGate E{kp->in[I_X], kp->out, WSP(float, WS_MOD) + 2048};
        pg8::gemm_phase(lds, g, S, E, tid);
    }
    GRID_SYNC();
    { PHASE_BEGIN
    for (int m = gw; m < T; m += NGW) { const float* md = WSP(float, WS_MOD) + (size_t)(m >> 11) * NMOD; norm_row_bf16(kp->out + (size_t)m * DM, kp->in[I_GN2], md + 4096, md + 3072, WSP(bf16_t, WS_H) + (size_t)m * DM, lane); } }
    GRID_SYNC();
    {
        PHASE_BEGIN
        pg8::Gemm g{WSP(bf16_t, WS_H), WSP(bf16_t, WS_WFFI), T, 2 * DFF, DM, DM, DM}; pg8::StaticOrder S; S.init(T, 2 * DFF, G, bx);
        pg8::EpiSwiglu E{WSP(bf16_t, WS_HF)};
        pg8::gemm_phase(lds, g, S, E, tid);
    }
    GRID_SYNC();
    {
        PHASE_BEGIN
        pg8::Gemm g{WSP(bf16_t, WS_HF), WSP(bf16_t, WS_WFFO), T, DM, DFF, DFF, DFF}; pg8::StaticOrder S; S.init(T, DM, G, bx);
        pg8::EpiResGate E{kp->out, kp->out, WSP(float, WS_MOD) + 5120};
        pg8::gemm_phase(lds, g, S, E, tid);
    }
    GRID_SYNC();
    { PHASE_BEGIN
    for (int m = gw; m < T; m += NGW) {
        f32x4* xr = (f32x4*)(kp->out + (size_t)m * DM) + lane;
        f32x4 v[4]; float s = 0.f;
#pragma unroll
        for (int j = 0; j < 4; ++j) { v[j] = xr[64 * j]; s += (v[j].x * v[j].x + v[j].y * v[j].y) + (v[j].z * v[j].z + v[j].w * v[j].w); }
        const float rstd = rsqrtf(wave_sum(s) * (1.f / DM) + EPS);
#pragma unroll
        for (int j = 0; j < 4; ++j) { const f32x4 g = *(const f32x4*)(kp->in[I_GFIN] + 4 * lane + 256 * j); xr[64 * j] = v[j] * rstd * g; }
    } }
}

extern "C" void kernel_launch(void* const* d_in, const int* in_sizes, int n_in, void* d_out, int out_size, void* d_ws, size_t ws_size, hipStream_t stream) {
    static int grid = 0;
    if (grid == 0) {
        if (n_in != 18 || out_size != T * DM || ws_size < WS_END) { fprintf(stderr, "kernel_launch: unexpected shapes (n_in %d out %d ws %zu)\n", n_in, out_size, ws_size); grid = -1; return; }
        int dev = 0, cus = 0, per_cu = 0;
        (void)hipGetDevice(&dev);
        (void)hipDeviceGetAttribute(&cus, hipDeviceAttributeMultiprocessorCount, dev);
        (void)hipFuncSetAttribute((const void*)fwd_kernel, hipFuncAttributeMaxDynamicSharedMemorySize, LDS_BYTES);
        (void)hipOccupancyMaxActiveBlocksPerMultiprocessor(&per_cu, (const void*)fwd_kernel, 512, LDS_BYTES);
        grid = (per_cu >= 1 && cus == 256) ? cus : -1;
        if (grid < 0) { fprintf(stderr, "kernel_launch: needs 256 CUs with one resident workgroup each (cus %d per_cu %d)\n", cus, per_cu); return; }
    }
    if (grid < 0) return;
    if (hipMemsetAsync((char*)d_ws + WS_BAR, 0, 16384, stream) != hipSuccess) { fprintf(stderr, "kernel_launch: memset failed\n"); return; }
    Args a{};
    for (int i = 0; i < 18; ++i) a.in[i] = (const float*)d_in[i];
    a.out = (float*)d_out; a.ws = (unsigned char*)d_ws;
    void* kargs[] = {&a};
    hipError_t e = hipLaunchCooperativeKernel((const void*)fwd_kernel, dim3(grid), dim3(512), kargs, LDS_BYTES, stream);
    if (e != hipSuccess) fprintf(stderr, "cooperative launch failed: %s\n", hipGetErrorString(e));
}
```
